# Optimizing an MI355X kernel written in HIP

```python
import math
import jax
import jax.numpy as jnp
from jax import lax
import numpy as np

D_MODEL = 2048
BATCH = 16
SEQ = 2048
DEPTH = 4

DIFF_WIDTH = D_MODEL // 2
DN_WIDTH = D_MODEL - DIFF_WIDTH
DIFF_HEAD_DIM = 64
N_DIFF_HEADS = DIFF_WIDTH // (2 * DIFF_HEAD_DIM)
DIFF_QK = 2 * N_DIFF_HEADS * DIFF_HEAD_DIM
DIFF_V = N_DIFF_HEADS * 2 * DIFF_HEAD_DIM
DN_HEAD_DIM = 128
N_DN_HEADS = DN_WIDTH // DN_HEAD_DIM
MIX_WIDTH = DIFF_V + DN_WIDTH
D_FF = 5632
CONV_K = 4
CHUNK = 64
Q_BLOCK = 128
ROPE_THETA = 500000.0
ROPE_DIM = DIFF_HEAD_DIM // 4
DEEPNORM_ALPHA = (2 * DEPTH) ** 0.25
DEEPNORM_BETA = (8 * DEPTH) ** -0.25
LN_EPS = 1e-5
SUBLN_EPS = 1e-5
GATED_NORM_EPS = 1e-6
L2_EPS = 1e-6
IN_SIZES = (DIFF_QK, DIFF_QK, DIFF_V, DN_WIDTH, DN_WIDTH, DN_WIDTH, DN_WIDTH, N_DN_HEADS, N_DN_HEADS)
IN_WIDTH = sum(IN_SIZES)

kernel_name = 'hymba_diffattn_gdn_macaron_deepnorm'


def layer_norm(x, g, b):
    xf = x.astype(jnp.float32)
    mu = jnp.mean(xf, axis=-1, keepdims=True)
    var = jnp.mean(jnp.square(xf - mu), axis=-1, keepdims=True)
    return ((xf - mu) * lax.rsqrt(var + LN_EPS) * g + b).astype(x.dtype)


def rms_norm(x, g, eps):
    xf = x.astype(jnp.float32)
    return (xf * lax.rsqrt(jnp.mean(jnp.square(xf), axis=-1, keepdims=True) + eps) * g).astype(x.dtype)


def l2_norm(x):
    return x * lax.rsqrt(jnp.sum(jnp.square(x), axis=-1, keepdims=True) + L2_EPS)


def swiglu(x, w_in, w_out):
    gate, up = jnp.split(x @ w_in, 2, axis=-1)
    return (jax.nn.silu(gate) * up) @ w_out


def rope_tables(positions):
    inv_freq = ROPE_THETA ** (-jnp.arange(0, ROPE_DIM, 2, dtype=jnp.float32) / ROPE_DIM)
    ang = positions.astype(jnp.float32)[..., None] * inv_freq
    return jnp.cos(ang)[:, :, None, :], jnp.sin(ang)[:, :, None, :]


def partial_rope(x, cos, sin):
    half = ROPE_DIM // 2
    x1 = x[..., :half].astype(jnp.float32)
    x2 = x[..., half:ROPE_DIM].astype(jnp.float32)
    rot = jnp.concatenate([x1 * cos - x2 * sin, x2 * cos + x1 * sin], axis=-1).astype(x.dtype)
    return jnp.concatenate([rot, x[..., ROPE_DIM:]], axis=-1)


def causal_depthwise_conv(u, w):
    S = u.shape[1]
    u_pad = jnp.pad(u, ((0, 0), (CONV_K - 1, 0), (0, 0)))
    return sum(w[j] * u_pad[:, j:j + S] for j in range(CONV_K))


def diff_attention(q, k, v, lam):
    S = q.shape[3]
    n_blk = S // Q_BLOCK
    scale = DIFF_HEAD_DIM ** -0.5
    k_pos = jnp.arange(S)

    def one_block(i):
        q_blk = lax.dynamic_slice_in_dim(q, i * Q_BLOCK, Q_BLOCK, axis=3)
        s = jnp.einsum('bhcqd,bhckd->bhcqk', q_blk, k).astype(jnp.float32) * scale
        q_pos = i * Q_BLOCK + jnp.arange(Q_BLOCK)
        s = jnp.where(k_pos[None, :] <= q_pos[:, None], s, -jnp.inf)
        p = jax.nn.softmax(s, axis=-1)
        p = p[:, :, 0] - lam * p[:, :, 1]
        return jnp.einsum('bhqk,bhkd->bhqd', p.astype(v.dtype), v)

    o = lax.map(one_block, jnp.arange(n_blk))
    B, H = q.shape[0], q.shape[1]
    return jnp.transpose(o, (1, 0, 3, 2, 4)).reshape(B, S, H, v.shape[-1])


def chunk_gated_delta_rule(q, k, v, beta, g):
    B, H, S, dk = q.shape
    dv = v.shape[-1]
    n = S // CHUNK
    q = q * dk ** -0.5
    q, k, v = (t.reshape(B, H, n, CHUNK, t.shape[-1]) for t in (q, k, v))
    beta = beta.reshape(B, H, n, CHUNK)
    g = jnp.cumsum(g.reshape(B, H, n, CHUNK), axis=-1)
    idx = jnp.arange(CHUNK)
    incl = idx[:, None] >= idx[None, :]
    strict = idx[:, None] > idx[None, :]
    decay = jnp.exp(jnp.where(incl, g[..., :, None] - g[..., None, :], -jnp.inf))
    k_beta = k * beta[..., None]
    L = jnp.where(strict, jnp.einsum('bhncd,bhnkd->bhnck', k_beta, k) * decay, 0.0)
    a = L + jnp.eye(CHUNK, dtype=jnp.float32)
    rhs = jnp.concatenate([v * beta[..., None], k_beta * jnp.exp(g)[..., None]], axis=-1)
    sol = lax.linalg.triangular_solve(a, rhs, left_side=True, lower=True, unit_diagonal=True)
    u, w = sol[..., :dv], sol[..., dv:]
    attn_intra = jnp.einsum('bhncd,bhnkd->bhnck', q, k) * decay
    g_last = g[..., -1:]
    q_dec = q * jnp.exp(g)[..., None]
    k_dec = k * jnp.exp(g_last - g)[..., None]
    chunk_decay = jnp.exp(g_last[..., 0])
    xs = tuple(jnp.moveaxis(t, 2, 0) for t in (q_dec, k_dec, u, w, attn_intra, chunk_decay))

    def step(state, inp):
        qd, kd, u_c, w_c, A, cd = inp
        v_new = u_c - jnp.einsum('bhck,bhkv->bhcv', w_c, state)
        o = jnp.einsum('bhck,bhkv->bhcv', qd, state) + jnp.einsum('bhcj,bhjv->bhcv', A, v_new)
        state = state * cd[..., None, None] + jnp.einsum('bhck,bhcv->bhkv', kd, v_new)
        return state, o

    s0 = jnp.zeros((B, H, dk, dv), jnp.float32)
    _, o = lax.scan(step, s0, xs)
    return jnp.moveaxis(o, 0, 2).reshape(B, H, S, dv)


def hybrid_mixer(x, cos, sin, w_in, conv_w, a_log, dt_bias, lam_q1, lam_k1, lam_q2, lam_k2,
                 diff_norm_g, delta_norm_g, w_out, lam_init):
    B, S, _ = x.shape
    offsets = tuple(int(o) for o in np.cumsum(IN_SIZES)[:-1])
    aq, ak, av, dq, dk, dv, dz, db, da = jnp.split(x @ w_in, offsets, axis=-1)

    aq = partial_rope(aq.reshape(B, S, 2 * N_DIFF_HEADS, DIFF_HEAD_DIM), cos, sin)
    ak = partial_rope(ak.reshape(B, S, 2 * N_DIFF_HEADS, DIFF_HEAD_DIM), cos, sin)
    aq = jnp.transpose(aq.reshape(B, S, N_DIFF_HEADS, 2, DIFF_HEAD_DIM), (0, 2, 3, 1, 4))
    ak = jnp.transpose(ak.reshape(B, S, N_DIFF_HEADS, 2, DIFF_HEAD_DIM), (0, 2, 3, 1, 4))
    av = jnp.transpose(av.reshape(B, S, N_DIFF_HEADS, 2 * DIFF_HEAD_DIM), (0, 2, 1, 3))
    lam = (jnp.exp(jnp.sum(lam_q1.astype(jnp.float32) * lam_k1.astype(jnp.float32)))
           - jnp.exp(jnp.sum(lam_q2.astype(jnp.float32) * lam_k2.astype(jnp.float32))) + lam_init)
    o_diff = diff_attention(aq, ak, av, lam)
    o_diff = (rms_norm(o_diff, diff_norm_g, SUBLN_EPS) * (1.0 - lam_init)).reshape(B, S, DIFF_V)

    qkv = jax.nn.silu(causal_depthwise_conv(jnp.concatenate([dq, dk, dv], axis=-1), conv_w))
    dq, dk, dv = jnp.split(qkv, 3, axis=-1)
    heads = lambda t: jnp.transpose(t.reshape(B, S, N_DN_HEADS, DN_HEAD_DIM), (0, 2, 1, 3)).astype(jnp.float32)
    dq, dk, dv = l2_norm(heads(dq)), l2_norm(heads(dk)), heads(dv)
    beta = jnp.transpose(jax.nn.sigmoid(db.astype(jnp.float32)), (0, 2, 1))
    g = -jnp.exp(a_log.astype(jnp.float32)) * jax.nn.softplus(da.astype(jnp.float32) + dt_bias.astype(jnp.float32))
    g = jnp.transpose(g, (0, 2, 1))
    o_dn = chunk_gated_delta_rule(dq, dk, dv, beta, g)
    o_dn = jnp.transpose(o_dn, (0, 2, 1, 3)).astype(x.dtype)
    o_dn = rms_norm(o_dn, delta_norm_g, GATED_NORM_EPS) * jax.nn.silu(dz.reshape(B, S, N_DN_HEADS, DN_HEAD_DIM))
    o_dn = o_dn.reshape(B, S, DN_WIDTH)

    return jnp.concatenate([o_diff, o_dn], axis=-1) @ w_out


def setup_inputs(seed: int = 0) -> dict:
    key = jax.random.key(seed)
    ks = jax.random.split(key, 24)
    f32 = jnp.float32

    def nrm(k, shape, scale):
        return jax.random.normal(k, shape, f32) * scale

    x = nrm(ks[0], (BATCH, SEQ, D_MODEL), 1.0)
    offset = jax.random.randint(ks[1], (BATCH, 1), 0, 4096, dtype=jnp.int32)
    positions = offset + jnp.arange(SEQ, dtype=jnp.int32)[None, :]
    ffn1_w_in = nrm(ks[2], (DEPTH, D_MODEL, 2 * D_FF), D_MODEL ** -0.5)
    ffn1_w_out = nrm(ks[3], (DEPTH, D_FF, D_MODEL), D_FF ** -0.5 * DEEPNORM_BETA)
    ln1_g = 1.0 + nrm(ks[4], (DEPTH, D_MODEL), 0.02)
    ln1_b = nrm(ks[5], (DEPTH, D_MODEL), 0.02)
    w_in = nrm(ks[6], (DEPTH, D_MODEL, IN_WIDTH), D_MODEL ** -0.5)
    conv_w = nrm(ks[7], (DEPTH, CONV_K, 3 * DN_WIDTH), CONV_K ** -0.5)
    a_log = jnp.log(jax.random.uniform(ks[8], (DEPTH, N_DN_HEADS), f32, 1.0, 16.0))
    dt = jnp.exp(jax.random.uniform(ks[9], (DEPTH, N_DN_HEADS), f32, math.log(1e-3), math.log(1e-1)))
    dt_bias = dt + jnp.log(-jnp.expm1(-dt))
    lam_q1 = nrm(ks[10], (DEPTH, DIFF_HEAD_DIM), 0.1)
    lam_k1 = nrm(ks[11], (DEPTH, DIFF_HEAD_DIM), 0.1)
    lam_q2 = nrm(ks[12], (DEPTH, DIFF_HEAD_DIM), 0.1)
    lam_k2 = nrm(ks[13], (DEPTH, DIFF_HEAD_DIM), 0.1)
    diff_norm_g = 1.0 + nrm(ks[14], (DEPTH, 2 * DIFF_HEAD_DIM), 0.02)
    delta_norm_g = 1.0 + nrm(ks[15], (DEPTH, DN_HEAD_DIM), 0.02)
    w_out = nrm(ks[16], (DEPTH, MIX_WIDTH, D_MODEL), MIX_WIDTH ** -0.5 * DEEPNORM_BETA)
    ln2_g = 1.0 + nrm(ks[17], (DEPTH, D_MODEL), 0.02)
    ln2_b = nrm(ks[18], (DEPTH, D_MODEL), 0.02)
    ffn2_w_in = nrm(ks[19], (DEPTH, D_MODEL, 2 * D_FF), D_MODEL ** -0.5)
    ffn2_w_out = nrm(ks[20], (DEPTH, D_FF, D_MODEL), D_FF ** -0.5 * DEEPNORM_BETA)
    ln3_g = 1.0 + nrm(ks[21], (DEPTH, D_MODEL), 0.02)
    ln3_b = nrm(ks[22], (DEPTH, D_MODEL), 0.02)
    return {'x': x, 'positions': positions, 'ffn1_w_in': ffn1_w_in, 'ffn1_w_out': ffn1_w_out,
            'ln1_g': ln1_g, 'ln1_b': ln1_b, 'w_in': w_in, 'conv_w': conv_w, 'a_log': a_log,
            'dt_bias': dt_bias, 'lam_q1': lam_q1, 'lam_k1': lam_k1, 'lam_q2': lam_q2, 'lam_k2': lam_k2,
            'diff_norm_g': diff_norm_g, 'delta_norm_g': delta_norm_g, 'w_out': w_out,
            'ln2_g': ln2_g, 'ln2_b': ln2_b, 'ffn2_w_in': ffn2_w_in, 'ffn2_w_out': ffn2_w_out,
            'ln3_g': ln3_g, 'ln3_b': ln3_b}


def reference(x, positions, ffn1_w_in, ffn1_w_out, ln1_g, ln1_b, w_in, conv_w, a_log, dt_bias,
              lam_q1, lam_k1, lam_q2, lam_k2, diff_norm_g, delta_norm_g, w_out, ln2_g, ln2_b,
              ffn2_w_in, ffn2_w_out, ln3_g, ln3_b):
    cos, sin = rope_tables(positions)
    for l in range(DEPTH):
        lam_init = 0.8 - 0.6 * math.exp(-0.3 * l)
        x = layer_norm(DEEPNORM_ALPHA * x + 0.5 * swiglu(x, ffn1_w_in[l], ffn1_w_out[l]), ln1_g[l], ln1_b[l])
        mix = hybrid_mixer(x, cos, sin, w_in[l], conv_w[l], a_log[l], dt_bias[l], lam_q1[l], lam_k1[l],
                           lam_q2[l], lam_k2[l], diff_norm_g[l], delta_norm_g[l], w_out[l], lam_init)
        x = layer_norm(DEEPNORM_ALPHA * x + mix, ln2_g[l], ln2_b[l])
        x = layer_norm(DEEPNORM_ALPHA * x + 0.5 * swiglu(x, ffn2_w_in[l], ffn2_w_out[l]), ln3_g[l], ln3_b[l])
    return x
```

```cpp
#include <hip/hip_runtime.h>
#include <cstdio>
#include <cstdint>
namespace pg8 {
#define PG8_LAS __attribute__((address_space(3)))
typedef unsigned short bf16_t;
typedef short bf16x8 __attribute__((ext_vector_type(8)));
typedef float f32x4 __attribute__((ext_vector_type(4)));
typedef unsigned u32x4 __attribute__((ext_vector_type(4)));
constexpr int BM = 256, BK = 64, HALF = 128, HTB = HALF * BK * 2  , STAGE_BYTES = 8 * HTB, NXCD = 8, WGM = 8;

__host__ __device__ __forceinline__ int lds_byte(int r, int c) { const int st = (r >> 4) * 2 + (c >> 5), rr = r & 15, cc = c & 31, ob = rr * 64 + cc * 2; return st * 1024 + (ob ^ (((ob >> 9) & 1) << 5)); }
__host__ __device__ __forceinline__ void stage_rc(int b, int& R, int& C) { const int st = b / 1024, sb = b % 1024, swz = sb ^ (((sb >> 9) & 1) << 5); R = (st >> 1) * 16 + swz / 64; C = (st & 1) * 32 + (swz % 64) / 2; }
__host__ __device__ __forceinline__ int perm32(int rho) { const int n = rho >> 4, i = rho & 15; return 8 * (i >> 2) + 4 * n + (i & 3); }

struct Unit { int pm, pn; };
struct Gemm { const bf16_t* A; const bf16_t* Bt; int M, N, K; };

struct StaticOrder {
    int nM, nN, nwg, G, c;
    __host__ __device__ void init(int M, int N, int G_, int c_) { nM = M / BM; nN = N / BM; nwg = nM * nN; G = G_; c = c_; }
    __host__ __device__ bool next(int i, Unit& u) const {
        const long L = (long)i * G + c; if (L >= nwg) return false;
        int wgid = (int)L; { const int q = nwg / NXCD, r = nwg % NXCD, xcd = wgid % NXCD, off = wgid / NXCD; wgid = (xcd < r ? xcd * (q + 1) : r * (q + 1) + (xcd - r) * q) + off; }
        const int nig = WGM * nN, gid = wgid / nig, fm = gid * WGM, gsz = (nM - fm) < WGM ? (nM - fm) : WGM;
        u.pm = fm + ((wgid % nig) % gsz); u.pn = (wgid % nig) / gsz; return true;
    }
    __device__ __forceinline__ void a_ready(const Unit&) const {}
    __device__ __forceinline__ void done(const Unit&) const {}
};

__device__ __forceinline__ unsigned cvt_pk_bf16(float lo, float hi) { unsigned r; asm volatile("v_cvt_pk_bf16_f32 %0, %1, %2" : "=v"(r) : "v"(lo), "v"(hi)); return r; }
typedef float f32x2 __attribute__((ext_vector_type(2)));
__device__ __forceinline__ float silu_f(float g) { return g * __builtin_amdgcn_rcpf(1.0f + __builtin_amdgcn_exp2f(-1.4426950408889634f * g)); }
struct EpiSwiGLU {
    static constexpr bool PERM = true, AFTER_DRAIN = false;
    bf16_t* H; int ldh;
    __device__ __forceinline__ void operator()(const f32x4 (&acc)[2][2][4][2], const Unit& u, int wr, int wc, int fr, int fq) const {
        const int row0 = u.pm * BM + wr * 64 + fr, col0 = u.pn * HALF + wc * 32 + 8 * fq;
#pragma unroll
        for (int ai = 0; ai < 2; ++ai)
#pragma unroll
            for (int m = 0; m < 4; ++m) { bf16_t* rowp = H + (size_t)(row0 + ai * HALF + m * 16) * ldh + col0;
                const f32x4 g0 = acc[ai][0][m][0], g1 = acc[ai][0][m][1], u0 = acc[ai][1][m][0], u1 = acc[ai][1][m][1];
                u32x4 w; w.x = cvt_pk_bf16(silu_f(g0[0]) * u0[0], silu_f(g0[1]) * u0[1]); w.y = cvt_pk_bf16(silu_f(g0[2]) * u0[2], silu_f(g0[3]) * u0[3]);
                w.z = cvt_pk_bf16(silu_f(g1[0]) * u1[0], silu_f(g1[1]) * u1[1]); w.w = cvt_pk_bf16(silu_f(g1[2]) * u1[2], silu_f(g1[3]) * u1[3]);
                *(u32x4*)rowp = w; }
    }
};
struct EpiResF32 {
    static constexpr bool PERM = false, AFTER_DRAIN = false;
    const float* X; float* Y; int ldc; float alpha, s;
    __device__ __forceinline__ void operator()(const f32x4 (&acc)[2][2][4][2], const Unit& u, int wr, int wc, int fr, int fq) const {
        const int row0 = u.pm * BM + wr * 64 + fr, col0 = u.pn * BM + wc * 32 + 4 * fq;
#pragma unroll
        for (int ai = 0; ai < 2; ++ai)
#pragma unroll
            for (int m = 0; m < 4; ++m) { const size_t off = (size_t)(row0 + ai * HALF + m * 16) * ldc + col0;
#pragma unroll
                for (int bj = 0; bj < 2; ++bj)
#pragma unroll
                    for (int n = 0; n < 2; ++n) { const f32x4 x = *(const f32x4*)(X + off + bj * HALF + n * 16); *(f32x4*)(Y + off + bj * HALF + n * 16) = x * alpha + acc[ai][bj][m][n] * s; } }
    }
};
struct EpiInProj {
    static constexpr bool PERM = true, AFTER_DRAIN = false;
    bf16_t* P; int ldp; float* BA; const float* rope; float qscale;
    __device__ __forceinline__ void operator()(const f32x4 (&acc)[2][2][4][2], const Unit& u, int wr, int wc, int fr, int fq) const {
        const int row0 = u.pm * BM + wr * 64 + fr;
        if (u.pn == 28) {
            if (wc == 0 && fq < 2) {
#pragma unroll
                for (int ai = 0; ai < 2; ++ai)
#pragma unroll
                    for (int m = 0; m < 4; ++m) { float* p = BA + (size_t)(row0 + ai * HALF + m * 16) * 16 + 8 * fq; *(f32x4*)p = acc[ai][0][m][0]; *(f32x4*)(p + 4) = acc[ai][0][m][1]; }
            }
            return;
        }
        const bool rot = (u.pn < 8) && ((wc & 1) == 0) && (fq < 2);
        const float sc = (u.pn < 4) ? qscale : 1.0f;
        const int col0 = u.pn * BM + wc * 32 + 8 * fq;
#pragma unroll
        for (int ai = 0; ai < 2; ++ai)
#pragma unroll
            for (int m = 0; m < 4; ++m) { const int row = row0 + ai * HALF + m * 16; bf16_t* rowp = P + (size_t)row * ldp + col0;
                f32x4 cs = (f32x4){1.f, 1.f, 1.f, 1.f}, sn = (f32x4){0.f, 0.f, 0.f, 0.f};
                if (rot) { cs = *(const f32x4*)(rope + (size_t)row * 16 + 4 * fq); sn = *(const f32x4*)(rope + (size_t)row * 16 + 8 + 4 * fq); }
#pragma unroll
                for (int bj = 0; bj < 2; ++bj) { const f32x4 a = acc[ai][bj][m][0], b = acc[ai][bj][m][1];
                    const f32x4 v0 = (a * cs - b * sn) * sc, v1 = (b * cs + a * sn) * sc;
                    u32x4 w; w.x = cvt_pk_bf16(v0[0], v0[1]); w.y = cvt_pk_bf16(v0[2], v0[3]); w.z = cvt_pk_bf16(v1[0], v1[1]); w.w = cvt_pk_bf16(v1[2], v1[3]);
                    *(u32x4*)(rowp + bj * HALF) = w; } }
    }
};
template <class Epi, class Sched, bool ALIGN_EPI = false, bool SP2 = false>
__device__ __forceinline__ void gemm_phase(PG8_LAS unsigned char* lds, const Gemm g, const Sched& S, const Epi& E) {
    int tid_ = threadIdx.x; asm volatile("" : "+v"(tid_));
    const int tid = tid_, wid = __builtin_amdgcn_readfirstlane(tid >> 6), lane = tid & 63, wr = wid >> 2, wc = wid & 3, fr = lane & 15, fq = lane >> 4;
    const int K = g.K, nt = K / BK;
    unsigned voffA[2], voffB[2];
#pragma unroll
    for (int i = 0; i < 2; ++i) { int R, C; stage_rc(tid * 16 + i * 8192, R, C); const int Rb = Epi::PERM ? ((R & ~31) + perm32(R & 31)) : R;
        voffA[i] = (unsigned)(R * K + C) * 2u; voffB[i] = (unsigned)(Rb * K + C) * 2u; }
    const size_t kstep = (size_t)(BK * 2);
    const size_t hstep = (size_t)HALF * K * 2;
    const size_t tstep = 2 * hstep;
    const unsigned ldsw = (unsigned)wid * 1024u;
    const int aoff = lds_byte(wr * 64 + fr, fq * 8), boff = lds_byte(wc * 32 + fr, fq * 8);
#define PG8_SA(b, h) (((b) * 2 + (h)) * HTB)
#define PG8_SB(b, h) ((4 + (b) * 2 + (h)) * HTB)
#define PG8_STAGE(bufoff, gbase, voff) do { _Pragma("unroll") for (int _i = 0; _i < 2; ++_i) \
        __builtin_amdgcn_global_load_lds((const unsigned*)((const char*)(gbase) + (voff)[_i]), (PG8_LAS unsigned*)(lds + (bufoff) + ldsw + _i * 8192), 16, 0, 0); } while (0)
#define PG8_LDA(dst, b, h) do { _Pragma("unroll") for (int m = 0; m < 4; ++m) _Pragma("unroll") for (int k = 0; k < 2; ++k) dst[m][k] = *(const PG8_LAS bf16x8*)(lds + PG8_SA(b, h) + aoff + m * 2048 + k * 1024); } while (0)
#define PG8_LDB(dst, b, h) do { _Pragma("unroll") for (int n = 0; n < 2; ++n) _Pragma("unroll") for (int k = 0; k < 2; ++k) dst[n][k] = *(const PG8_LAS bf16x8*)(lds + PG8_SB(b, h) + boff + n * 2048 + k * 1024); } while (0)
#define PG8_MMA(ai, bj, At, Bt) do { __builtin_amdgcn_s_setprio(1); _Pragma("unroll") for (int m = 0; m < 4; ++m) _Pragma("unroll") for (int n = 0; n < 2; ++n) _Pragma("unroll") for (int k = 0; k < 2; ++k) \
        acc[ai][bj][m][n] = __builtin_amdgcn_mfma_f32_16x16x32_bf16(Bt[n][k], At[m][k], acc[ai][bj][m][n], 0, 0, 0); __builtin_amdgcn_s_setprio(0); } while (0)
#define PG8_WAIT_V(n) asm volatile("s_waitcnt vmcnt(" #n ")" ::: "memory")
#define PG8_WAIT_L(n) asm volatile("s_waitcnt lgkmcnt(" #n ")" ::: "memory")
#define PG8_BAR __builtin_amdgcn_s_barrier()
#define PG8_SCHED __builtin_amdgcn_sched_barrier(0)
    Unit cur, nxt; int ui = 0;
    if (!S.next(0, cur)) return;
    f32x4 acc[2][2][4][2];
#pragma unroll
    for (int a = 0; a < 2; ++a)
#pragma unroll
        for (int b = 0; b < 2; ++b)
#pragma unroll
            for (int m = 0; m < 4; ++m)
#pragma unroll
                for (int n = 0; n < 2; ++n) acc[a][b][m][n] = (f32x4){0.f, 0.f, 0.f, 0.f};
    bf16x8 At[4][2], B0[2][2], B1[2][2];
    const char* cA = (const char*)g.A + (size_t)cur.pm * tstep; const char* cB = (const char*)g.Bt + (size_t)cur.pn * tstep;
    S.a_ready(cur);
    if constexpr (SP2) {
        PG8_STAGE(PG8_SB(0, 0), cB, voffB); PG8_STAGE(PG8_SB(0, 1), cB + hstep, voffB); PG8_STAGE(PG8_SA(0, 0), cA, voffA); PG8_STAGE(PG8_SA(0, 1), cA + hstep, voffA);
        if (wr == 1) PG8_BAR;
        PG8_WAIT_V(2); PG8_BAR;
        PG8_STAGE(PG8_SB(1, 0), cB + kstep, voffB); PG8_STAGE(PG8_SA(1, 0), cA + kstep, voffA); PG8_STAGE(PG8_SB(1, 1), cB + hstep + kstep, voffB);
        PG8_WAIT_V(6); PG8_BAR;
    } else {
        PG8_STAGE(PG8_SB(0, 0), cB, voffB); PG8_STAGE(PG8_SA(0, 0), cA, voffA); PG8_STAGE(PG8_SB(0, 1), cB + hstep, voffB); PG8_STAGE(PG8_SA(0, 1), cA + hstep, voffA);
        if (wr == 1) PG8_BAR;
        PG8_WAIT_V(4); PG8_BAR;
        PG8_STAGE(PG8_SB(1, 0), cB + kstep, voffB); PG8_STAGE(PG8_SA(1, 0), cA + kstep, voffA); PG8_STAGE(PG8_SB(1, 1), cB + hstep + kstep, voffB);
        PG8_WAIT_V(6); PG8_BAR;
    }
    for (;;) {
        const bool has_next = S.next(ui + 1, nxt);
        const char* nA = has_next ? (const char*)g.A + (size_t)nxt.pm * tstep : cA; const char* nB = has_next ? (const char*)g.Bt + (size_t)nxt.pn * tstep : cB;
        for (int t = 0; t < nt; t += 2) {
            const bool last = (t == nt - 2);
            const char* a1 = cA + (size_t)(t + 1) * kstep;
            const char* a2 = last ? nA : cA + (size_t)(t + 2) * kstep; const char* b2 = last ? nB : cB + (size_t)(t + 2) * kstep;
            const char* a3 = a2 + kstep; const char* b3 = b2 + kstep;
            if (last && has_next) S.a_ready(nxt);
            if constexpr (SP2) {
            PG8_LDB(B0, 0, 0); PG8_LDB(B1, 0, 1); PG8_SCHED; PG8_LDA(At, 0, 0); PG8_STAGE(PG8_SA(1, 1), a1 + hstep, voffA);
            PG8_WAIT_V(8); PG8_WAIT_L(0); PG8_BAR; PG8_MMA(0, 0, At, B0); PG8_MMA(0, 1, At, B1); PG8_BAR; PG8_SCHED;
            PG8_LDA(At, 0, 1); PG8_STAGE(PG8_SB(0, 0), b2, voffB); PG8_STAGE(PG8_SB(0, 1), b2 + hstep, voffB); PG8_STAGE(PG8_SA(0, 0), a2, voffA);
            PG8_WAIT_V(8); PG8_WAIT_L(0); PG8_BAR; PG8_MMA(1, 0, At, B0); PG8_MMA(1, 1, At, B1); PG8_BAR; PG8_SCHED;
            PG8_LDB(B0, 1, 0); PG8_LDB(B1, 1, 1); PG8_SCHED; PG8_LDA(At, 1, 0); PG8_STAGE(PG8_SA(0, 1), a2 + hstep, voffA);
            PG8_WAIT_V(8); PG8_WAIT_L(0); PG8_BAR; PG8_MMA(0, 0, At, B0); PG8_MMA(0, 1, At, B1); PG8_BAR; PG8_SCHED;
            PG8_LDA(At, 1, 1); PG8_STAGE(PG8_SB(1, 0), b3, voffB); PG8_STAGE(PG8_SB(1, 1), b3 + hstep, voffB); PG8_STAGE(PG8_SA(1, 0), a3, voffA);
            PG8_WAIT_V(8); PG8_WAIT_L(0); PG8_BAR; PG8_MMA(1, 0, At, B0); PG8_MMA(1, 1, At, B1); PG8_BAR; PG8_SCHED;
            } else {
            PG8_LDB(B0, 0, 0); PG8_SCHED; PG8_LDA(At, 0, 0); PG8_STAGE(PG8_SA(1, 1), a1 + hstep, voffA);
            PG8_WAIT_L(8); PG8_BAR; PG8_WAIT_L(0); PG8_MMA(0, 0, At, B0); PG8_BAR; PG8_SCHED;
            PG8_LDB(B1, 0, 1); PG8_STAGE(PG8_SB(0, 0), b2, voffB);
            PG8_BAR; PG8_WAIT_L(0); PG8_MMA(0, 1, At, B1); PG8_BAR;
            PG8_LDA(At, 0, 1); PG8_STAGE(PG8_SA(0, 0), a2, voffA);
            PG8_BAR; PG8_WAIT_L(0); PG8_MMA(1, 0, At, B0); PG8_BAR; PG8_SCHED;
            PG8_STAGE(PG8_SB(0, 1), b2 + hstep, voffB);
            PG8_WAIT_V(6); PG8_BAR; PG8_MMA(1, 1, At, B1); PG8_BAR;
            PG8_LDB(B0, 1, 0); PG8_SCHED; PG8_LDA(At, 1, 0); PG8_STAGE(PG8_SA(0, 1), a2 + hstep, voffA);
            PG8_WAIT_L(8); PG8_BAR; PG8_WAIT_L(0); PG8_MMA(0, 0, At, B0); PG8_BAR; PG8_SCHED;
            PG8_LDB(B1, 1, 1); PG8_STAGE(PG8_SB(1, 0), b3, voffB);
            PG8_BAR; PG8_WAIT_L(0); PG8_MMA(0, 1, At, B1); PG8_BAR;
            PG8_LDA(At, 1, 1); PG8_STAGE(PG8_SA(1, 0), a3, voffA);
            PG8_BAR; PG8_WAIT_L(0); PG8_MMA(1, 0, At, B0); PG8_BAR; PG8_SCHED;
            PG8_STAGE(PG8_SB(1, 1), b3 + hstep, voffB);
            PG8_WAIT_V(6); PG8_BAR; PG8_MMA(1, 1, At, B1); PG8_BAR;
            }
        }
        if constexpr (ALIGN_EPI) { if (wr == 0) PG8_BAR; }
        if constexpr (!Epi::AFTER_DRAIN) { E(acc, cur, wr, wc, fr, fq); S.done(cur); }
        if (!has_next) break;
#pragma unroll
        for (int a = 0; a < 2; ++a)
#pragma unroll
            for (int b = 0; b < 2; ++b)
#pragma unroll
                for (int m = 0; m < 4; ++m)
#pragma unroll
                    for (int n = 0; n < 2; ++n) acc[a][b][m][n] = (f32x4){0.f, 0.f, 0.f, 0.f};
        cur = nxt; cA = nA; cB = nB; ++ui;
        if constexpr (ALIGN_EPI) { if (wr == 1) PG8_BAR; }
    }
    PG8_WAIT_V(0);
    if constexpr (!ALIGN_EPI) { if (wr == 0) PG8_BAR; }
    PG8_BAR;
    if constexpr (Epi::AFTER_DRAIN) { E.fused(acc, cur, wr, wc, fr, fq, lds, wid, lane); S.done(cur); }
#undef PG8_SA
#undef PG8_SB
#undef PG8_STAGE
#undef PG8_LDA
#undef PG8_LDB
#undef PG8_MMA
#undef PG8_WAIT_V
#undef PG8_WAIT_L
#undef PG8_BAR
#undef PG8_SCHED
}
}

#ifndef PG8_SP2
#define PG8_SP2 true
#endif
#ifndef PG8_ALIGN
#define PG8_ALIGN true
#endif
#include <hip/hip_bf16.h>
#include <cmath>
namespace attn_body {
using bf16=__hip_bfloat16;
using bf16x8=__attribute__((ext_vector_type(8)))short;
using s16x4=__attribute__((ext_vector_type(4)))short;
using f32x16=__attribute__((ext_vector_type(16)))float;
using u32x4=__attribute__((ext_vector_type(4)))unsigned;
constexpr int SEQ=2048,D=64,QKVP=7168,OPITCH=2048;
constexpr int NW=8,QBLK=32,QB=QBLK*NW,KVBLK=64,NQB=SEQ/QB;
constexpr int ATTN_UNIT_ROWS=QB;
__device__ __forceinline__ int crow(int r,int hi){return (r&3)+8*(r>>2)+4*hi;}
#define SBAR() __builtin_amdgcn_sched_barrier(0)
__device__ __forceinline__ void cmask(f32x16&p0,f32x16&p1,int jb,int qrel,int hi){
  const float NEG=-INFINITY; int kb=64*jb+4*hi;
  #pragma unroll
  for(int r=0;r<16;++r){int kv=kb+(r&3)+8*(r>>2); if(kv>qrel)p0[r]=NEG; if(kv+32>qrel)p1[r]=NEG;}
}

constexpr int NSLOT=3, SLOTB=8192;
constexpr int LDS_K=0, LDS_V=NSLOT*SLOTB, LDS_WS=2*NSLOT*SLOTB, LDS_OST=LDS_WS+NW*64*4, LDS_BYTES=LDS_OST+NW*4096;
constexpr float C2=0.125f*1.4426950408889634f;
__device__ __forceinline__ void glds16(const void*gsrc,unsigned lds_dst){unsigned keep;
  asm volatile("s_mov_b32 %0, m0\n\ts_mov_b32 m0, %2\n\ts_nop 0\n\tglobal_load_lds_dwordx4 %1, off\n\ts_mov_b32 m0, %0":"=&s"(keep):"v"(gsrc),"s"(lds_dst):"memory");}
__device__ __forceinline__ float max3f(float a,float b,float c){float r;asm("v_max3_f32 %0, %1, %2, %3":"=v"(r):"v"(a),"v"(b),"v"(c));return r;}
__device__ __forceinline__ float max2f(float a,float b){float r;asm("v_max_f32_e32 %0, %1, %2":"=v"(r):"v"(a),"v"(b));return r;}
__device__ __forceinline__ float fadd_s(float a,float b){float r;asm("v_add_f32_e32 %0, %1, %2":"=v"(r):"v"(a),"v"(b));return r;}
__device__ __forceinline__ float fsub_s(float a,float b){float r;asm("v_sub_f32_e32 %0, %1, %2":"=v"(r):"v"(a),"v"(b));return r;}
typedef float f32x2_t __attribute__((ext_vector_type(2))); typedef __bf16 bf16x2_t __attribute__((ext_vector_type(2)));
__device__ __forceinline__ unsigned cvtpk_s(float lo,float hi){f32x2_t v={lo,hi};bf16x2_t b=__builtin_convertvector(v,bf16x2_t);return __builtin_bit_cast(unsigned,b);}
#define WAIT_BAR(N) asm volatile("s_waitcnt vmcnt(" #N ") lgkmcnt(0)\n\ts_barrier":::"memory")

__device__ __forceinline__ void qkt(f32x16&p0,f32x16&p1,const char*Kslot,const bf16x8*qr,const f32x16&negm,int r32,int hi){
  const char*kb=Kslot+hi*1024+r32*16;
  #pragma unroll
  for(int d0=0;d0<4;++d0){
    const bf16x8 b0=*reinterpret_cast<const bf16x8*>(kb+d0*2048);
    const bf16x8 b1=*reinterpret_cast<const bf16x8*>(kb+d0*2048+512);
    if(d0==0){p0=__builtin_amdgcn_mfma_f32_32x32x16_bf16(b0,qr[0],negm,0,0,0);p1=__builtin_amdgcn_mfma_f32_32x32x16_bf16(b1,qr[0],negm,0,0,0);}
    else{p0=__builtin_amdgcn_mfma_f32_32x32x16_bf16(b0,qr[d0],p0,0,0,0);p1=__builtin_amdgcn_mfma_f32_32x32x16_bf16(b1,qr[d0],p1,0,0,0);}}
}
typedef __attribute__((address_space(3))) const char* lds_cptr;
typedef short v4i16_t __attribute__((ext_vector_type(4)));
__device__ __forceinline__ void kload8(bf16x8*kf,lds_cptr kp){
  kf[0]=*(const __attribute__((address_space(3))) bf16x8*)(kp);      kf[1]=*(const __attribute__((address_space(3))) bf16x8*)(kp+512);
  kf[2]=*(const __attribute__((address_space(3))) bf16x8*)(kp+2048); kf[3]=*(const __attribute__((address_space(3))) bf16x8*)(kp+2560);
  kf[4]=*(const __attribute__((address_space(3))) bf16x8*)(kp+4096); kf[5]=*(const __attribute__((address_space(3))) bf16x8*)(kp+4608);
  kf[6]=*(const __attribute__((address_space(3))) bf16x8*)(kp+6144); kf[7]=*(const __attribute__((address_space(3))) bf16x8*)(kp+6656);
}
__device__ __forceinline__ void kload2(bf16x8*kf,lds_cptr kp,int j){ kf[2*j]=*(const __attribute__((address_space(3))) bf16x8*)(kp+j*2048); kf[2*j+1]=*(const __attribute__((address_space(3))) bf16x8*)(kp+j*2048+512); }
__device__ __forceinline__ s16x4 vtr(lds_cptr p){ return __builtin_bit_cast(s16x4,__builtin_amdgcn_ds_read_tr16_b64_v4i16((__attribute__((address_space(3))) v4i16_t*)p)); }
__device__ __forceinline__ float rowmax(const f32x16&p0,const f32x16&p1){
  float a=max3f(p0[0],p0[1],p1[0]),b=max3f(p0[2],p0[3],p1[1]);a=max3f(a,p1[2],p1[3]);
  #pragma unroll
  for(int r=4;r<16;r+=4){a=max3f(a,p0[r],p0[r+1]);b=max3f(b,p0[r+2],p0[r+3]);a=max3f(a,p1[r],p1[r+1]);b=max3f(b,p1[r+2],p1[r+3]);}
  const float m=max2f(a,b);
  auto rr=__builtin_amdgcn_permlane32_swap(__float_as_uint(m),__float_as_uint(m),false,false);
  return max2f(__uint_as_float(rr[0]),__uint_as_float(rr[1]));
}
__device__ __forceinline__ void pv(f32x16*o,int vb,bf16x8 pa0,bf16x8 pa1,bf16x8 pa2,bf16x8 pa3){
  #pragma unroll
  for(int d0=0;d0<2;++d0){s16x4 lo[4],hi[4];
    #pragma unroll
    for(int ks=0;ks<4;++ks){
      asm volatile("ds_read_b64_tr_b16 %0,%1 offset:%c2":"=&v"(lo[ks]):"v"(vb),"i"(d0*4096+ks*1024):"memory");
      asm volatile("ds_read_b64_tr_b16 %0,%1 offset:%c2":"=&v"(hi[ks]):"v"(vb),"i"(d0*4096+ks*1024+512):"memory");}
    asm volatile("s_waitcnt lgkmcnt(0)":::"memory");SBAR();
    #define PK(k) (bf16x8){lo[k][0],lo[k][1],lo[k][2],lo[k][3],hi[k][0],hi[k][1],hi[k][2],hi[k][3]}
    o[d0]=__builtin_amdgcn_mfma_f32_32x32x16_bf16(pa0,PK(0),o[d0],0,0,0);
    o[d0]=__builtin_amdgcn_mfma_f32_32x32x16_bf16(pa1,PK(1),o[d0],0,0,0);
    o[d0]=__builtin_amdgcn_mfma_f32_32x32x16_bf16(pa2,PK(2),o[d0],0,0,0);
    o[d0]=__builtin_amdgcn_mfma_f32_32x32x16_bf16(pa3,PK(3),o[d0],0,0,0);
    #undef PK
  }
}

#ifndef ATTN_STORE16
#define ATTN_STORE16(p,v) (*(u32x4*)(p)=(v))
#endif
template<int THRL> __device__ __forceinline__ void attn_unit(int b,int h,int qb,const bf16*Q,const bf16*__restrict__ K,const bf16*__restrict__ V,bf16*O,char*shm){
  int tid_=threadIdx.x; asm volatile("":"+v"(tid_)); const int tid=tid_,lane=tid&63,r32=lane&31,hi=lane>>5; const int wid=__builtin_amdgcn_readfirstlane(tid>>6);
  const long rowbase=(long)b*SEQ; const int q0=qb*QB;
  const bf16*Qw=Q+(rowbase+q0+wid*QBLK)*QKVP;
  const bf16*Kh=K+rowbase*QKVP,*Vh=V+rowbase*QKVP;
  const unsigned lds0=(unsigned)(uintptr_t)shm;
  float*wsf=(float*)(shm+LDS_WS)+wid*64;
  const bf16*ksrc=Kh+(long)lane*QKVP+wid*8;
  const bf16*vsrc=Vh+(long)(16*(wid&3)+(lane>>2))*QKVP+(wid>>2)*32+(lane&3)*8;
  const unsigned kdst=lds0+LDS_K+wid*1024, vdst=lds0+LDS_V+wid*1024;
  #define DMA_K(t,slot) glds16(ksrc+(long)(t)*KVBLK*QKVP,(unsigned)__builtin_amdgcn_readfirstlane(kdst+(slot)))
  #define DMA_V(t,slot) glds16(vsrc+(long)(t)*KVBLK*QKVP,(unsigned)__builtin_amdgcn_readfirstlane(vdst+(slot)))
  const int vb0=(int)(lds0+LDS_V)+((lane>>4)&1)*32+(lane&3)*8+(4*hi+((lane&15)>>2))*64;
  const char*Kbase=shm+LDS_K; bf16x8 kf[8];
  const lds_cptr shm3=(lds_cptr)shm; const lds_cptr kp0=shm3+LDS_K+hi*1024+r32*16; const lds_cptr vp0=shm3+LDS_V+((lane>>4)&1)*32+(lane&3)*8+(4*hi+((lane&15)>>2))*64;
  const int NT=(q0+QB)/KVBLK;
  DMA_K(0,0);DMA_V(0,0);DMA_K(1,SLOTB);
  bf16x8 qr[4];
  #pragma unroll
  for(int d0=0;d0<4;++d0)qr[d0]=*reinterpret_cast<const bf16x8*>(&Qw[(long)r32*QKVP+d0*16+hi*8]);
  float mhat=0.f,l_reg=0.f;f32x16 o[2];o[0]=f32x16{};o[1]=f32x16{};f32x16 negm=f32x16{};asm volatile("":"+v"(negm));
  const int qrel=wid*QBLK+r32;
  #define CMASK(P0,P1,t) do{int jb_=(t)-(NT-4); if(jb_>=0)cmask(P0,P1,jb_,qrel,hi);}while(0)
  bool resc=false;
  #define START(P0,P1) do{ const float rm=rowmax(P0,P1); resc=false; \
    { const float dl=rm; mhat=fadd_s(mhat,dl); \
      _Pragma("unroll") for(int r=0;r<16;++r){P0[r]=fsub_s(P0[r],dl);P1[r]=fsub_s(P1[r],dl);} \
      _Pragma("unroll") for(int r=0;r<16;++r)negm[r]=-mhat; asm volatile("":"+v"(negm)); } \
    _Pragma("unroll") for(int r=0;r<16;++r)P0[r]=__builtin_amdgcn_exp2f(P0[r]); }while(0)
  #define RESC() do{ if(resc){ asm volatile("s_waitcnt lgkmcnt(0)":::"memory"); \
      _Pragma("unroll") for(int d_=0;d_<2;++d_) _Pragma("unroll") for(int r=0;r<16;++r)o[d_][r]*=wsf[crow(r,hi)]; } }while(0)
  f32x16 pA0,pA1,pB0,pB1;
  int sl_prev=0,sl_cur=0,sl_next=SLOTB;
  #define ROT() do{sl_prev=sl_cur;sl_cur=sl_next;sl_next=(sl_next==(NSLOT-1)*SLOTB)?0:sl_next+SLOTB;}while(0)
  DMA_K(2,2*SLOTB);
  WAIT_BAR(3);
  qkt(pA0,pA1,Kbase,qr,negm,r32,hi);asm volatile("s_nop 15\n\ts_nop 7":"+v"(pA0),"+v"(pA1));CMASK(pA0,pA1,0);
  START(pA0,pA1);
  _Pragma("unroll") for(int r=0;r<16;++r)pA1[r]=__builtin_amdgcn_exp2f(pA1[r]);
  WAIT_BAR(0);
  DMA_K(3,0);DMA_V(1,SLOTB);
  ROT();
  kload8(kf,kp0+sl_cur);
  WAIT_BAR(2);
  s16x4 vlo[8],vhi[8]; u32x4 pw0,pw1,pw2,pw3;
  #define PKW(P,B) cvtpk_s(P[B],P[B+1])
  #define PAF(k) __builtin_bit_cast(bf16x8,pw##k)
  #define VFR(i) (bf16x8){vlo[i][0],vlo[i][1],vlo[i][2],vlo[i][3],vhi[i][0],vhi[i][1],vhi[i][2],vhi[i][3]}
  #define PIN(x) asm volatile("":"+v"(x))
  #define MX3(a,b,c) __builtin_fmaxf(__builtin_fmaxf((a),(b)),(c))
  #define GAPA(MF,A0,A1,A2,A3,W0,W1,PW) do{ MF; sacc+=A0; sacc+=A1; sacc+=A2; sacc+=A3; PIN(sacc); W0; W1; PIN(PW); SBAR(); }while(0)
  #define EX(v) __builtin_amdgcn_exp2f(v)
  #define GAPB(MF,X,B) do{ MF; X[B]=EX(X[B]); X[B+1]=EX(X[B+1]); X[B+2]=EX(X[B+2]); X[B+3]=EX(X[B+3]); PIN(X); SBAR(); }while(0)
  #define VRD(i) do{ vlo[i]=vtr(vp_+(((i)>>2)*4096+((i)&3)*1024)); vhi[i]=vtr(vp_+(((i)>>2)*4096+((i)&3)*1024+512)); }while(0)
  #define KRD(G,j) do{ if(G){ kload2(kf,kp0+sl_next,j); SBAR(); } }while(0)
  #define STEP(C0,C1,P0,P1,t,GK,GV,GL) do{ SBAR(); \
    const lds_cptr vp_=vp0+sl_prev; \
    VRD(0); SBAR(); float sacc=(P0[0]+P0[1]); \
    GAPA(C0=__builtin_amdgcn_mfma_f32_32x32x16_bf16(kf[0],qr[0],negm,0,0,0), P0[2],P0[3],P0[4],P0[5],     pw0[0]=PKW(P0,0), pw0[1]=PKW(P0,2), pw0); \
    VRD(4); SBAR(); GAPA(C1=__builtin_amdgcn_mfma_f32_32x32x16_bf16(kf[1],qr[0],negm,0,0,0), P0[6],P0[7],P0[8],P0[9],     pw0[2]=PKW(P0,4), pw0[3]=PKW(P0,6), pw0); \
    VRD(1); SBAR(); GAPA(C0=__builtin_amdgcn_mfma_f32_32x32x16_bf16(kf[2],qr[1],C0,0,0,0),   P0[10],P0[11],P0[12],P0[13], pw1[0]=PKW(P0,8), pw1[1]=PKW(P0,10), pw1); \
    VRD(5); SBAR(); GAPA(C1=__builtin_amdgcn_mfma_f32_32x32x16_bf16(kf[3],qr[1],C1,0,0,0),   P0[14],P0[15],P1[0],P1[1],   pw1[2]=PKW(P0,12),pw1[3]=PKW(P0,14), pw1); \
    VRD(2); SBAR(); GAPA(C0=__builtin_amdgcn_mfma_f32_32x32x16_bf16(kf[4],qr[2],C0,0,0,0),   P1[2],P1[3],P1[4],P1[5],     pw2[0]=PKW(P1,0), pw2[1]=PKW(P1,2), pw2); \
    VRD(6); SBAR(); GAPA(C1=__builtin_amdgcn_mfma_f32_32x32x16_bf16(kf[5],qr[2],C1,0,0,0),   P1[6],P1[7],P1[8],P1[9],     pw2[2]=PKW(P1,4), pw2[3]=PKW(P1,6), pw2); \
    VRD(3); SBAR(); GAPA(C0=__builtin_amdgcn_mfma_f32_32x32x16_bf16(kf[6],qr[3],C0,0,0,0),   P1[10],P1[11],P1[12],P1[13], pw3[0]=PKW(P1,8), pw3[1]=PKW(P1,10), pw3); \
    VRD(7); SBAR(); GAPA(C1=__builtin_amdgcn_mfma_f32_32x32x16_bf16(kf[7],qr[3],C1,0,0,0),   P1[14],P1[15],0.f,0.f,       pw3[2]=PKW(P1,12),pw3[3]=PKW(P1,14), pw3); \
    l_reg+=sacc; \
    if(GK){DMA_K((t)+3,sl_cur);} if(GV){DMA_V((t)+1,sl_next);} \
    CMASK(C0,C1,t); \
    { float a=MX3(C0[0],C0[1],C1[0]),b=MX3(C0[2],C0[3],C1[1]); a=MX3(a,C1[2],C1[3]); \
      _Pragma("unroll") for(int r=4;r<16;r+=4){a=MX3(a,C0[r],C0[r+1]);b=MX3(b,C0[r+2],C0[r+3]);a=MX3(a,C1[r],C1[r+1]);b=MX3(b,C1[r+2],C1[r+3]);} \
      float rm=__builtin_fmaxf(a,b); { auto rr=__builtin_amdgcn_permlane32_swap(__float_as_uint(rm),__float_as_uint(rm),false,false); rm=__builtin_fmaxf(__uint_as_float(rr[0]),__uint_as_float(rr[1])); } \
      resc=false; \
      if(__builtin_expect(__any(rm>(float)THRL),0)){ const float dl=__builtin_fmaxf(rm,0.f); mhat+=dl; \
        _Pragma("unroll") for(int r=0;r<16;++r){C0[r]-=dl;C1[r]-=dl;} \
        _Pragma("unroll") for(int r=0;r<16;++r)negm[r]=-mhat; asm volatile("":"+v"(negm)); \
        const float f=__builtin_amdgcn_exp2f(-dl); l_reg*=f; if(hi==0)wsf[r32]=f; resc=true; } } \
    SBAR(); \
    GAPB(o[0]=__builtin_amdgcn_mfma_f32_32x32x16_bf16(PAF(0),VFR(0),o[0],0,0,0), C0,0); \
    GAPB(o[1]=__builtin_amdgcn_mfma_f32_32x32x16_bf16(PAF(0),VFR(4),o[1],0,0,0), C0,4); \
    KRD(GL,0); GAPB(o[0]=__builtin_amdgcn_mfma_f32_32x32x16_bf16(PAF(1),VFR(1),o[0],0,0,0), C0,8); \
    KRD(GL,1); GAPB(o[1]=__builtin_amdgcn_mfma_f32_32x32x16_bf16(PAF(1),VFR(5),o[1],0,0,0), C0,12); \
    KRD(GL,2); GAPB(o[0]=__builtin_amdgcn_mfma_f32_32x32x16_bf16(PAF(2),VFR(2),o[0],0,0,0), C1,0); \
    KRD(GL,3); GAPB(o[1]=__builtin_amdgcn_mfma_f32_32x32x16_bf16(PAF(2),VFR(6),o[1],0,0,0), C1,4); \
    GAPB(o[0]=__builtin_amdgcn_mfma_f32_32x32x16_bf16(PAF(3),VFR(3),o[0],0,0,0), C1,8); \
    GAPB(o[1]=__builtin_amdgcn_mfma_f32_32x32x16_bf16(PAF(3),VFR(7),o[1],0,0,0), C1,12); \
    }while(0)
  int t=1;
  #undef CMASK
  #define CMASK(P0,P1,t) do{}while(0)
  for(;t+5<NT;t+=2){
    STEP(pB0,pB1,pA0,pA1,t,true,true,true);     WAIT_BAR(2); RESC(); ROT();
    STEP(pA0,pA1,pB0,pB1,t+1,true,true,true);   WAIT_BAR(2); RESC(); ROT();
  }
  #undef CMASK
  #define CMASK(P0,P1,t) do{int jb_=(t)-(NT-4); if(jb_>=0)cmask(P0,P1,jb_,qrel,hi);}while(0)
  #define ENDW(tt) do{ if((tt)+3<NT){WAIT_BAR(2);} else if((tt)+2<NT){WAIT_BAR(1);} else {WAIT_BAR(0);} }while(0)
  for(;t+1<NT;t+=2){
    STEP(pB0,pB1,pA0,pA1,t,(t+3<NT),(t+1<NT),(t+1<NT));       ENDW(t);   RESC(); ROT();
    STEP(pA0,pA1,pB0,pB1,t+1,(t+4<NT),(t+2<NT),(t+2<NT));     ENDW(t+1); RESC(); ROT();
  }
  STEP(pB0,pB1,pA0,pA1,NT-1,false,false,false); RESC();
  { float sacc=pB0[0]+pB0[1]; _Pragma("unroll") for(int r=2;r<16;++r)sacc+=pB0[r]; _Pragma("unroll") for(int r=0;r<16;++r)sacc+=pB1[r]; l_reg+=sacc;
    pw0=(u32x4){PKW(pB0,0),PKW(pB0,2),PKW(pB0,4),PKW(pB0,6)};pw1=(u32x4){PKW(pB0,8),PKW(pB0,10),PKW(pB0,12),PKW(pB0,14)};pw2=(u32x4){PKW(pB1,0),PKW(pB1,2),PKW(pB1,4),PKW(pB1,6)};pw3=(u32x4){PKW(pB1,8),PKW(pB1,10),PKW(pB1,12),PKW(pB1,14)};
    SBAR(); pv(o,vb0+sl_cur,PAF(0),PAF(1),PAF(2),PAF(3)); }
  #undef PKW
  #undef PAF
  #undef VFR
  #undef PIN
  #undef MX3
  #undef GAPA
  #undef GAPB
  #undef EX
  #undef VRD
  #undef KRD
  #undef STEP
  #undef ENDW
  {auto rr=__builtin_amdgcn_permlane32_swap(__float_as_uint(l_reg),__float_as_uint(l_reg),false,false);l_reg=__uint_as_float(rr[0])+__uint_as_float(rr[1]);}
  if(hi==0)wsf[32+r32]=l_reg;asm volatile("s_waitcnt lgkmcnt(0)":::"memory");
  float rli[16];
  #pragma unroll
  for(int r=0;r<16;++r)rli[r]=__builtin_amdgcn_rcpf(wsf[32+crow(r,hi)]);
  bf16*Ow=O+(rowbase+q0+wid*QBLK)*OPITCH;
  { bf16*stg=(bf16*)(shm+LDS_OST)+wid*2048;
    #pragma unroll
    for(int r=0;r<16;++r){const int orow=crow(r,hi);
      #pragma unroll
      for(int d0=0;d0<2;++d0)stg[orow*64+d0*32+r32]=__float2bfloat16(o[d0][r]*rli[r]);}
    asm volatile("s_waitcnt lgkmcnt(0)":::"memory");
    #pragma unroll
    for(int i=0;i<4;++i){const int row=i*8+(lane>>3),ch=lane&7; const u32x4 v=*(const u32x4*)(stg+row*64+ch*8); ATTN_STORE16(Ow+(long)row*OPITCH+ch*8,v);} }
  asm volatile("s_waitcnt lgkmcnt(0)\n\ts_barrier":::"memory");
  #undef DMA_K
  #undef DMA_V
  #undef CMASK
  #undef START
  #undef RESC
  #undef ROT
}
constexpr int ATTN_LDS_BYTES=LDS_BYTES;
template<int THRL=8> __device__ __forceinline__ void attn_phase(char*lds,const bf16*P,bf16*O,int vcu,int G){
  for(int v=vcu; v<256; v+=G){
    const int b=v>>4, h=(v>>1)&7, c=v&1;
    for(int i=0;i<16;++i){ const int vh=i>>3, qb=7-(i&7);
      attn_unit<THRL>(b,0,qb,P+(h*2+c)*64,P+1024+(h*2+c)*64,P+2048+h*128+vh*64,O+((h*2+c)*2+vh)*64,lds); }
  }
}
#undef SBAR
#undef WAIT_BAR
}
#define GAS __attribute__((address_space(1)))
#define LAS __attribute__((address_space(3)))
typedef unsigned short bf16;
typedef unsigned v4u __attribute__((ext_vector_type(4)));
typedef float f32x4 __attribute__((ext_vector_type(4)));
typedef short bf16x8 __attribute__((ext_vector_type(8)));
typedef GAS unsigned gu32;
typedef GAS unsigned long long gu64;
#define RLX_AGENT __ATOMIC_RELAXED, __HIP_MEMORY_SCOPE_AGENT
#define LDS_WAIT() asm volatile("s_waitcnt lgkmcnt(0)" ::: "memory")
#define VM_WAIT() asm volatile("s_waitcnt vmcnt(0)" ::: "memory")
__device__ __forceinline__ unsigned long long rt() { return __builtin_amdgcn_s_memrealtime(); }
__device__ __forceinline__ unsigned f2bf(float f) { unsigned u = __builtin_bit_cast(unsigned, f); return (u + 0x7fffu + ((u >> 16) & 1u)) >> 16; }
__device__ __forceinline__ unsigned pk2(float lo, float hi) { return f2bf(lo) | (f2bf(hi) << 16); }

#define XB_TMO      128
#define XB_XCNT(j)  (256  + 64 * (j))
#define XB_XSUB(j)  (1280 + 64 * (j))
#define XB_XGEN(j)  (2304 + 64 * (j))
#define XB_TOP      3328
#define XB_TOPGEN   3392
#define XCD_BAR_WORDS 3456
#define XB_SPIN_CAP (1u << 18)

__device__ __forceinline__ unsigned xb_ld(unsigned* p)              { return __hip_atomic_load(p, __ATOMIC_RELAXED, __HIP_MEMORY_SCOPE_AGENT); }
__device__ __forceinline__ unsigned xb_add(unsigned* p, unsigned v) { return __hip_atomic_fetch_add(p, v, __ATOMIC_RELAXED, __HIP_MEMORY_SCOPE_AGENT); }
__device__ __forceinline__ unsigned xb_xcc_id() { return (unsigned)__builtin_amdgcn_s_getreg((3 << 11) | 20) & 0xFu; }
#define XB_SPIN(cond, bar) do { unsigned _sp = 0; while (cond) { __builtin_amdgcn_s_sleep(1); \
    if ((++_sp & 255u) == 0u) { if (xb_ld(&(bar)[XB_TMO])) break; if (_sp > XB_SPIN_CAP) { atomicAdd(&(bar)[XB_TMO], 1u); break; } } } } while (0)

struct XcdBarrier {
    unsigned* bar; unsigned x;
    volatile LAS unsigned* st;
};

__device__ __forceinline__ XcdBarrier xcd_barrier_post(unsigned* bar, volatile LAS unsigned* st) {
    XcdBarrier b; b.bar = bar; b.x = xb_xcc_id(); b.st = st;
    if (threadIdx.x == 0) (void)xb_add(&bar[XB_XCNT(b.x)], 1u);
    return b;
}
__device__ __forceinline__ void xcd_barrier_complete(unsigned* bar, unsigned x, unsigned& nloc, unsigned& nx) {
    const unsigned G = gridDim.x * gridDim.y * gridDim.z;
    unsigned sum, cnt, mine, sp = 0u;
    for (;;) {
        sum = 0u; cnt = 0u; mine = 0u;
#pragma unroll
        for (unsigned j = 0; j < 16; ++j) { const unsigned c = xb_ld(&bar[XB_XCNT(j)]); sum += c; cnt += (c > 0u) ? 1u : 0u; mine = (j == x) ? c : mine; }
        if (sum == G) break;
        __builtin_amdgcn_s_sleep(1);
        if ((++sp & 255u) == 0u) { if (xb_ld(&bar[XB_TMO])) break; if (sp > XB_SPIN_CAP) { atomicAdd(&bar[XB_TMO], 1u); break; } }
    }
    nloc = mine > 0u ? mine : 1u; nx = cnt > 0u ? cnt : 1u;
}

__device__ __forceinline__ void xcd_barrier(const XcdBarrier& b) {
    asm volatile("s_waitcnt vmcnt(0)" ::: "memory");
    __syncthreads();
    if (threadIdx.x == 0) {
        unsigned* bar = b.bar;
        __builtin_amdgcn_s_waitcnt(0);
        unsigned nloc = b.st[0], nx = b.st[1];
        if (nloc == 0u) { xcd_barrier_complete(bar, b.x, nloc, nx); b.st[0] = nloc; b.st[1] = nx; }
        const unsigned old = xb_add(&bar[XB_XSUB(b.x)], 1u);
        const unsigned gen = old / nloc;
        if (old + 1u == (gen + 1u) * nloc) {
            __builtin_amdgcn_fence(__ATOMIC_RELEASE, "agent");
            asm volatile("s_waitcnt vmcnt(0)" ::: "memory");
            const unsigned og = xb_add(&bar[XB_TOP], 1u);
            const unsigned tg = og / nx;
            if (og + 1u == (tg + 1u) * nx) xb_add(&bar[XB_TOPGEN], 1u);
            else XB_SPIN(xb_ld(&bar[XB_TOPGEN]) == tg, bar);
            __builtin_amdgcn_fence(__ATOMIC_ACQUIRE, "agent");
            xb_add(&bar[XB_XGEN(b.x)], 1u);
            asm volatile("s_waitcnt vmcnt(0)" ::: "memory");
        } else {
            XB_SPIN(xb_ld(&bar[XB_XGEN(b.x)]) == gen, bar);
            __builtin_amdgcn_fence(__ATOMIC_ACQUIRE, "agent");
            asm volatile("s_waitcnt vmcnt(0)" ::: "memory");
        }
    }
    __syncthreads();
}
#ifndef MK_ONE_LAUNCH
#define MK_ONE_LAUNCH 0
#endif
constexpr int NWAVES = 8;
constexpr int BATCH = 16, SEQ = 2048, D = 2048, DEPTH = 4, M = BATCH * SEQ;
constexpr int DFF = 5632, NFI = 2 * DFF;
constexpr int NIN = 7184, NINP = 7424, PW = 7168;
constexpr int NH = 8;
constexpr float LN_EPS = 1e-5f, SUBLN_EPS = 1e-5f, GN_EPS = 1e-6f, L2_EPS = 1e-6f;
constexpr float ALPHA = 1.681792830507429f;
constexpr float QSCALE = 0.125f * 1.4426950408889634f;
constexpr int NFFN = 2 * DEPTH, SLOTS = 11, NPH = 1 + SLOTS * NFFN;

constexpr size_t MiB = 1u << 20;
constexpr size_t WS_CTL = 0, CTL_ZERO_BYTES = 1 * MiB;
constexpr size_t WS_ROPE = 1 * MiB, WS_BA = 3 * MiB;
constexpr size_t WS_WFI = 8 * MiB, WS_WFO = 52 * MiB, WS_WIN = 74 * MiB, WS_WOUT = 103 * MiB;
constexpr size_t WS_XB = 112 * MiB, WS_MIX = 240 * MiB, WS_HP = 368 * MiB, WS_QKVN = 816 * MiB, WS_O = 1008 * MiB, WS_END = 1136 * MiB;
static_assert(WS_WFI + (size_t)NFI * D * 2 <= WS_WFO && WS_WFO + (size_t)D * DFF * 2 <= WS_WIN && WS_WIN + (size_t)NINP * D * 2 <= WS_WOUT && WS_WOUT + (size_t)D * D * 2 <= WS_XB, "weights map");
static_assert(WS_XB + (size_t)M * D * 2 <= WS_MIX && WS_MIX + (size_t)M * D * 2 <= WS_HP && WS_HP + (size_t)M * PW * 2 <= WS_QKVN && WS_QKVN + (size_t)M * 3072 * 2 <= WS_O && WS_O + (size_t)M * D * 2 <= WS_END, "act map");
constexpr int CW_TMO = 0, CW_CODE = 1, CW_BAR = 4096;

constexpr int RING_OFF = 0, RING_BYTES = 131072;
constexpr int LDSCTL_OFF = RING_BYTES, MISC_OFF = LDSCTL_OFF + 320;
constexpr int LDS_BYTES = 147456;
static_assert(MISC_OFF + 128 <= LDS_BYTES, "LDS map");
__device__ __forceinline__ float wave_sum(float v) {
#pragma unroll
    for (int o = 1; o < 64; o <<= 1) v += __shfl_xor(v, o);
    return v;
}
__device__ __forceinline__ float bf2f(unsigned short h) { return __builtin_bit_cast(float, (unsigned)h << 16); }
__device__ __forceinline__ float bflo(unsigned w) { return __builtin_bit_cast(float, w << 16); }
__device__ __forceinline__ float bfhi(unsigned w) { return __builtin_bit_cast(float, w & 0xffff0000u); }
__device__ __forceinline__ float silu(float g) { return g / (1.0f + __expf(-g)); }

template <class RowMap>
__device__ __forceinline__ void transpose_item(const float* W, int K, int N, int NP, bf16* WT, const RowMap& rm, LAS float* scr, int item, int lane) {
    const int nblk = NP / 32, kb = item / nblk, nb = item % nblk, k0 = 64 * kb, n0 = 32 * nb;
    const int nn = n0 + (lane & 31); const bool ok = nn < N;
#pragma unroll 8
    for (int i = 0; i < 32; ++i) { const int kk = 2 * i + (lane >> 5); scr[kk * 33 + (lane & 31)] = ok ? W[(size_t)(k0 + kk) * N + nn] : 0.f; }
    LDS_WAIT(); asm volatile("" ::: "memory");
    const int c = lane & 7;
#pragma unroll
    for (int j = 0; j < 4; ++j) { const int n = (lane >> 3) + 8 * j; const LAS float* s = scr + (8 * c) * 33 + n;
        v4u o; o.x = pk2(s[0 * 33], s[1 * 33]); o.y = pk2(s[2 * 33], s[3 * 33]); o.z = pk2(s[4 * 33], s[5 * 33]); o.w = pk2(s[6 * 33], s[7 * 33]);
        *(GAS v4u*)(WT + (size_t)rm(n0 + n) * K + k0 + 8 * c) = o; }
    LDS_WAIT(); asm volatile("" ::: "memory");
}
struct RmId { __device__ __forceinline__ int operator()(int n) const { return n; } };
struct RmFfnIn { __device__ __forceinline__ int operator()(int n) const { const int up = n >= DFF, j = n - up * DFF; return (j >> 7) * 256 + up * 128 + (j & 127); } };
struct RmMixIn { __device__ __forceinline__ int operator()(int n) const { if (n >= 2048) return n; const int p = n & 63; if (p >= 4 && p < 12) return (n & ~63) + (p ^ 12); return n; } };

__device__ __forceinline__ void ln_row(const float* yrow, float* xrow, bf16* brow, const float* g, const float* b, int lane) {
    const GAS f32x4* yr = (const GAS f32x4*)yrow + lane;
    f32x4 v[8]; float s = 0.f;
#pragma unroll
    for (int j = 0; j < 8; ++j) { v[j] = yr[64 * j]; s += (v[j].x + v[j].y) + (v[j].z + v[j].w); }
    const float mean = wave_sum(s) * (1.f / D); float s2 = 0.f;
#pragma unroll
    for (int j = 0; j < 8; ++j) { v[j] = v[j] - mean; s2 += (v[j].x * v[j].x + v[j].y * v[j].y) + (v[j].z * v[j].z + v[j].w * v[j].w); }
    const float rstd = 1.f / sqrtf(wave_sum(s2) * (1.f / D) + LN_EPS);
    GAS f32x4* xo = (GAS f32x4*)xrow + lane; GAS unsigned long long* o8 = (GAS unsigned long long*)brow + lane;
    const GAS f32x4* gp = (const GAS f32x4*)g + lane; const GAS f32x4* bp = (const GAS f32x4*)b + lane;
#pragma unroll
    for (int j = 0; j < 8; ++j) { const f32x4 o = v[j] * rstd * gp[64 * j] + bp[64 * j]; xo[64 * j] = o;
        o8[64 * j] = (unsigned long long)pk2(o.x, o.y) | ((unsigned long long)pk2(o.z, o.w) << 32); }
}
struct Args { const void* in[23]; float* out; unsigned char* ws; int ph_lo, ph_hi; };
enum { I_X = 0, I_POS, I_F1IN, I_F1OUT, I_LN1G, I_LN1B, I_WIN, I_CONVW, I_ALOG, I_DTB, I_LQ1, I_LK1, I_LQ2, I_LK2, I_DIFFG, I_DELTAG, I_WOUT, I_LN2G, I_LN2B, I_F2IN, I_F2OUT, I_LN3G, I_LN3B, I_OUT, I_WS };
constexpr int PTAB_OFF = LDSCTL_OFF + 512;
__device__ __forceinline__ unsigned char* ptab(int i) {
    extern __shared__ __attribute__((aligned(16))) unsigned char lds[];
    const LAS unsigned* t = (const LAS unsigned*)((LAS unsigned char*)lds + PTAB_OFF) + 2 * i;
    const unsigned lo = __builtin_amdgcn_readfirstlane(t[0]), hi = __builtin_amdgcn_readfirstlane(t[1]);
    return (unsigned char*)(GAS unsigned char*)(((unsigned long long)hi << 32) | lo);
}
#define PH_BEGIN() asm volatile("" ::: "memory"); int tid = threadIdx.x; asm volatile("" : "+v"(tid)); int bx_ = blockIdx.x; asm volatile("" : "+s"(bx_)); \
    const int lane = tid & 63, wave = __builtin_amdgcn_readfirstlane(tid >> 6), G = gridDim.x, vcu = (G % 8 == 0) ? (bx_ % 8) * (G / 8) + bx_ / 8 : bx_; \
    unsigned char* const ws = ptab(I_WS); (void)lane; (void)wave; (void)vcu; (void)ws
#define GWAVES() const int gw = vcu * NWAVES + wave, NGW = G * NWAVES
#define PIN_F(i) ((const float*)ptab(i))

__global__ void __launch_bounds__(NWAVES * 64, 2) hyb_fwd(Args args) {
    extern __shared__ __attribute__((aligned(16))) unsigned char lds[];
    LAS unsigned char* const L = (LAS unsigned char*)lds;
    for (int u = threadIdx.x; u < (LDS_BYTES - LDSCTL_OFF) / 4; u += NWAVES * 64) ((LAS unsigned*)(L + LDSCTL_OFF))[u] = 0u;
    __syncthreads();
    if (threadIdx.x == 0) { LAS unsigned long long* t = (LAS unsigned long long*)(L + PTAB_OFF);
#pragma unroll
        for (int i = 0; i < 23; ++i) t[i] = (unsigned long long)args.in[i];
        t[I_OUT] = (unsigned long long)args.out; t[I_WS] = (unsigned long long)args.ws; }
    __syncthreads();
    const int lo = args.ph_lo, hi = args.ph_hi;
    if (hi - lo > 1) (void)xcd_barrier_post((unsigned*)((gu32*)args.ws + CW_BAR), (volatile LAS unsigned*)(L + MISC_OFF) + 8);
#define IN(k) (lo <= (k) && (k) < hi)
#define SEAM(k) do { if ((k) + 1 < hi) { XcdBarrier b_; b_.bar = (unsigned*)ptab(I_WS) + CW_BAR; b_.x = xb_xcc_id(); b_.st = (volatile LAS unsigned*)(L + MISC_OFF) + 8; xcd_barrier(b_); } } while (0)

    if (IN(0)) {
        PH_BEGIN(); const int gt = vcu * (NWAVES * 64) + tid, NGT = G * NWAVES * 64;
        const int* pos = (const int*)ptab(I_POS); const float* x_in = PIN_F(I_X); float* ROPE = (float*)(ws + WS_ROPE); bf16* XB = (bf16*)(ws + WS_XB);
        for (int i = gt; i < M * 8; i += NGT) { const int r = i >> 3, k = i & 7;
            const double ang = (double)pos[r] * pow(500000.0, -(double)(2 * k) / 16.0);
            ROPE[(size_t)r * 16 + k] = (float)cos(ang); ROPE[(size_t)r * 16 + 8 + k] = (float)sin(ang); }
        for (size_t i = (size_t)gt; i < (size_t)M * D / 4; i += NGT) { const f32x4 v = ((const GAS f32x4*)x_in)[i];
            ((GAS unsigned long long*)XB)[i] = (unsigned long long)pk2(v.x, v.y) | ((unsigned long long)pk2(v.z, v.w) << 32); }
        SEAM(0);
    }

    for (int fi = 0; fi < NFFN; ++fi) {
        const int l = fi >> 1, second = fi & 1, pb = 1 + SLOTS * fi;
        if (IN(pb + 0)) {
            PH_BEGIN(); GWAVES(); LAS float* scr = (LAS float*)(L + RING_OFF + wave * 16384);
            const float* w_in_f = PIN_F(second ? I_F2IN : I_F1IN) + (size_t)l * D * NFI; const float* w_out_f = PIN_F(second ? I_F2OUT : I_F1OUT) + (size_t)l * DFF * D;
            bf16* WFI = (bf16*)(ws + WS_WFI); bf16* WFO = (bf16*)(ws + WS_WFO);
            constexpr int I_A = (D / 64) * (NFI / 32), I_B = (DFF / 64) * (D / 32);
            for (int it = gw; it < I_A + I_B; it += NGW) {
                if (it < I_A) transpose_item(w_in_f, D, NFI, NFI, WFI, RmFfnIn(), scr, it, lane);
                else transpose_item(w_out_f, DFF, D, D, WFO, RmId(), scr, it - I_A, lane);
            }
            SEAM(pb + 0);
        }
        if (IN(pb + 1)) {
            PH_BEGIN();
            pg8::Gemm g{(const bf16*)(ws + WS_XB), (const bf16*)(ws + WS_WFI), M, NFI, D}; pg8::StaticOrder S; S.init(M, NFI, G, bx_);
            pg8::EpiSwiGLU E{(bf16*)(ws + WS_HP), DFF};
            pg8::gemm_phase<pg8::EpiSwiGLU, pg8::StaticOrder, PG8_ALIGN, PG8_SP2>(L + RING_OFF, g, S, E);
            SEAM(pb + 1);
        }
        if (IN(pb + 2)) {
            PH_BEGIN(); float* XF = (float*)ptab(I_OUT);
            pg8::Gemm g{(const bf16*)(ws + WS_HP), (const bf16*)(ws + WS_WFO), M, D, DFF}; pg8::StaticOrder S; S.init(M, D, G, bx_);
            pg8::EpiResF32 E{fi == 0 ? PIN_F(I_X) : (const float*)XF, XF, D, ALPHA, 0.5f};
            pg8::gemm_phase<pg8::EpiResF32, pg8::StaticOrder, PG8_ALIGN, PG8_SP2>(L + RING_OFF, g, S, E);
            SEAM(pb + 2);
        }
        if (IN(pb + 3)) {
            PH_BEGIN(); GWAVES(); float* XF = (float*)ptab(I_OUT); bf16* XB = (bf16*)(ws + WS_XB);
            const float* lng = PIN_F(second ? I_LN3G : I_LN1G) + (size_t)l * D; const float* lnb = PIN_F(second ? I_LN3B : I_LN1B) + (size_t)l * D;
            for (int m = gw; m < M; m += NGW) ln_row(XF + (size_t)m * D, XF + (size_t)m * D, XB + (size_t)m * D, lng, lnb, lane);
            SEAM(pb + 3);
        }
        if (second) continue;
        if (IN(pb + 4)) {
            PH_BEGIN(); GWAVES(); LAS float* scr = (LAS float*)(L + RING_OFF + wave * 16384);
            const float* wi = PIN_F(I_WIN) + (size_t)l * D * NIN; const float* wo = PIN_F(I_WOUT) + (size_t)l * D * D;
            bf16* WIN = (bf16*)(ws + WS_WIN); bf16* WOUT = (bf16*)(ws + WS_WOUT);
            constexpr int I_A = (D / 64) * (NINP / 32), I_B = (D / 64) * (D / 32);
            for (int it = gw; it < I_A + I_B; it += NGW) {
                if (it < I_A) transpose_item(wi, D, NIN, NINP, WIN, RmMixIn(), scr, it, lane);
                else transpose_item(wo, D, D, D, WOUT, RmId(), scr, it - I_A, lane);
            }
            SEAM(pb + 4);
        }
        if (IN(pb + 5)) {
            PH_BEGIN();
            pg8::Gemm g{(const bf16*)(ws + WS_XB), (const bf16*)(ws + WS_WIN), M, NINP, D}; pg8::StaticOrder S; S.init(M, NINP, G, bx_);
            pg8::EpiInProj E{(bf16*)(ws + WS_HP), PW, (float*)(ws + WS_BA), (const float*)(ws + WS_ROPE), QSCALE};
            pg8::gemm_phase<pg8::EpiInProj, pg8::StaticOrder, PG8_ALIGN, PG8_SP2>(L + RING_OFF, g, S, E);
            SEAM(pb + 5);
        }
        if (IN(pb + 6)) {
            { PH_BEGIN(); GWAVES(); const bf16* HP = (const bf16*)(ws + WS_HP); bf16* QKVN = (bf16*)(ws + WS_QKVN);
            const float* cw = PIN_F(I_CONVW) + (size_t)l * 4 * 3072;
            for (int task = gw; task < M * 24; task += NGW) { const int r = task / 24, hh = task - r * 24, ch = hh * 128 + 2 * lane, s = r & (SEQ - 1);
                float a0 = 0.f, a1 = 0.f;
#pragma unroll
                for (int j = 0; j < 4; ++j) { if (s - 3 + j >= 0) { const unsigned w = *(const GAS unsigned*)(HP + (size_t)(r - 3 + j) * PW + 3072 + ch);
                        a0 += cw[j * 3072 + ch] * bflo(w); a1 += cw[j * 3072 + ch + 1] * bfhi(w); } }
                a0 = silu(a0); a1 = silu(a1);
                if (hh < 16) { const float ss = wave_sum(a0 * a0 + a1 * a1); float rn = 1.0f / sqrtf(ss + L2_EPS); if (hh < 8) rn *= 0.08838834764831845f; a0 *= rn; a1 *= rn; }
                *(GAS unsigned*)(QKVN + (size_t)r * 3072 + ch) = pk2(a0, a1); }
            VM_WAIT(); __syncthreads(); }
#ifndef NO_ATTN
            { PH_BEGIN();
            attn_body::attn_phase<8>((char*)lds + RING_OFF, (const attn_body::bf16*)(ws + WS_HP), (attn_body::bf16*)(ws + WS_O), vcu, G); }
#endif
            SEAM(pb + 6);
        }
#ifndef NO_SCAN
        if (IN(pb + 7)) {
            PH_BEGIN(); const bf16* QKVN = (const bf16*)(ws + WS_QKVN); const float* BA = (const float*)(ws + WS_BA); bf16* MIX = (bf16*)(ws + WS_MIX);
            const float* alog = PIN_F(I_ALOG) + l * NH; const float* dtb = PIN_F(I_DTB) + l * NH;
            LAS float* qs = (LAS float*)(L + RING_OFF); LAS float* ks = qs + 32 * 128; LAS float* vs = ks + 32 * 128; LAS float* gb = vs + 32 * 128;
            for (int pair = vcu; pair < BATCH * NH; pair += G) { const int b = pair >> 3, h = pair & 7, j = tid >> 2, part = tid & 3;
                float S[32];
#pragma unroll
                for (int i = 0; i < 32; ++i) S[i] = 0.f;
                const float aexp = __expf(alog[h]), dt = dtb[h];
                for (int t0 = 0; t0 < SEQ; t0 += 32) {
                    __syncthreads();
                    for (int idx = tid; idx < 32 * 384; idx += NWAVES * 64) { const int tt = idx / 384, c = idx - tt * 384, sec = c >> 7, cc = c & 127;
                        const float v = bf2f(QKVN[(size_t)(b * SEQ + t0 + tt) * 3072 + sec * 1024 + h * 128 + cc]); qs[sec * 4096 + tt * 128 + cc] = v; }
                    if (tid < 32) { const size_t r = (size_t)(b * SEQ + t0 + tid); const float db = BA[r * 16 + h], da = BA[r * 16 + 8 + h] + dt;
                        const float sp = da > 20.f ? da : log1pf(__expf(da)); gb[tid * 2] = __expf(-aexp * sp); gb[tid * 2 + 1] = 1.0f / (1.0f + __expf(-db)); }
                    __syncthreads();
                    for (int tt = 0; tt < 32; ++tt) {
                        const float a = gb[tt * 2], beta = gb[tt * 2 + 1], vt = vs[tt * 128 + j];
                        const LAS f32x4* kp = (const LAS f32x4*)(ks + tt * 128 + part * 32); const LAS f32x4* qp = (const LAS f32x4*)(qs + tt * 128 + part * 32);
                        float kv = 0.f;
#pragma unroll
                        for (int i = 0; i < 8; ++i) { const f32x4 k4 = kp[i]; kv += k4.x * S[4 * i] + k4.y * S[4 * i + 1] + k4.z * S[4 * i + 2] + k4.w * S[4 * i + 3]; }
                        kv += __shfl_xor(kv, 1); kv += __shfl_xor(kv, 2);
                        const float vn = beta * (vt - a * kv);
                        float o = 0.f;
#pragma unroll
                        for (int i = 0; i < 8; ++i) { const f32x4 k4 = kp[i], q4 = qp[i];
                            S[4 * i] = a * S[4 * i] + k4.x * vn; S[4 * i + 1] = a * S[4 * i + 1] + k4.y * vn; S[4 * i + 2] = a * S[4 * i + 2] + k4.z * vn; S[4 * i + 3] = a * S[4 * i + 3] + k4.w * vn;
                            o += q4.x * S[4 * i] + q4.y * S[4 * i + 1] + q4.z * S[4 * i + 2] + q4.w * S[4 * i + 3]; }
                        o += __shfl_xor(o, 1); o += __shfl_xor(o, 2);
                        if (part == 0) MIX[(size_t)(b * SEQ + t0 + tt) * D + 1024 + h * 128 + j] = (bf16)f2bf(o);
                    }
                }
            }
            SEAM(pb + 7);
        }
#endif
        if (IN(pb + 8)) {
            PH_BEGIN(); GWAVES(); const bf16* OB = (const bf16*)(ws + WS_O); const bf16* HP = (const bf16*)(ws + WS_HP); bf16* MIX = (bf16*)(ws + WS_MIX);
            const float lam_init = 0.8f - 0.6f * expf(-0.3f * (float)l);
            const float* q1 = PIN_F(I_LQ1) + l * 64; const float* k1 = PIN_F(I_LK1) + l * 64; const float* q2 = PIN_F(I_LQ2) + l * 64; const float* k2 = PIN_F(I_LK2) + l * 64;
            const float lam = expf(wave_sum(q1[lane] * k1[lane])) - expf(wave_sum(q2[lane] * k2[lane])) + lam_init;
            const float* dg = PIN_F(I_DIFFG) + l * 128; const float* eg = PIN_F(I_DELTAG) + l * 128;
            const float g0 = dg[2 * lane] * (1.0f - lam_init), g1 = dg[2 * lane + 1] * (1.0f - lam_init), e0 = eg[2 * lane], e1 = eg[2 * lane + 1];
            for (int task = gw; task < M * 16; task += NGW) { const int r = task >> 4, hh = task & 15;
                if (hh < 8) { const int h = hh, vh = lane >> 5, dd = (2 * lane) & 63;
                    const unsigned w1 = *(const GAS unsigned*)(OB + (size_t)r * D + ((h * 2 + 0) * 2 + vh) * 64 + dd), w2 = *(const GAS unsigned*)(OB + (size_t)r * D + ((h * 2 + 1) * 2 + vh) * 64 + dd);
                    const float o0 = bflo(w1) - lam * bflo(w2), o1 = bfhi(w1) - lam * bfhi(w2);
                    const float rn = 1.0f / sqrtf(wave_sum(o0 * o0 + o1 * o1) * (1.f / 128.f) + SUBLN_EPS);
                    *(GAS unsigned*)(MIX + (size_t)r * D + h * 128 + 2 * lane) = pk2(o0 * rn * g0, o1 * rn * g1);
                } else { const int h = hh - 8; GAS unsigned* p = (GAS unsigned*)(MIX + (size_t)r * D + 1024 + h * 128 + 2 * lane);
                    const unsigned w = *p, z = *(const GAS unsigned*)(HP + (size_t)r * PW + 6144 + h * 128 + 2 * lane);
                    const float o0 = bflo(w), o1 = bfhi(w);
                    const float rn = 1.0f / sqrtf(wave_sum(o0 * o0 + o1 * o1) * (1.f / 128.f) + GN_EPS);
                    *p = pk2(o0 * rn * e0 * silu(bflo(z)), o1 * rn * e1 * silu(bfhi(z)));
                }
            }
            SEAM(pb + 8);
        }
        if (IN(pb + 9)) {
            PH_BEGIN(); float* XF = (float*)ptab(I_OUT);
            pg8::Gemm g{(const bf16*)(ws + WS_MIX), (const bf16*)(ws + WS_WOUT), M, D, D}; pg8::StaticOrder S; S.init(M, D, G, bx_);
            pg8::EpiResF32 E{(const float*)XF, XF, D, ALPHA, 1.0f};
            pg8::gemm_phase<pg8::EpiResF32, pg8::StaticOrder, PG8_ALIGN, PG8_SP2>(L + RING_OFF, g, S, E);
            SEAM(pb + 9);
        }
        if (IN(pb + 10)) {
            PH_BEGIN(); GWAVES(); float* XF = (float*)ptab(I_OUT); bf16* XB = (bf16*)(ws + WS_XB);
            const float* g2 = PIN_F(I_LN2G) + (size_t)l * D; const float* b2 = PIN_F(I_LN2B) + (size_t)l * D;
            for (int m = gw; m < M; m += NGW) ln_row(XF + (size_t)m * D, XF + (size_t)m * D, XB + (size_t)m * D, g2, b2, lane);
            SEAM(pb + 10);
        }
    }
#undef IN
#undef SEAM
}

extern "C" void kernel_launch(void* const* d_in, const int* in_sizes, int n_in, void* d_out, int out_size, void* d_ws, size_t ws_size, hipStream_t stream) {
    static int grid = 0;
    if (grid == 0) {
        if (n_in != 23 || in_sizes[0] != M * D || out_size != M * D || ws_size < WS_END) { fprintf(stderr, "kernel_launch: unexpected shapes (n_in %d, in0 %d, out %d, ws %zu); nothing launched\n", n_in, n_in > 0 ? in_sizes[0] : -1, out_size, ws_size); grid = -1; return; }
        int dev = 0, cus = 0, per_cu = 0;
        if (hipGetDevice(&dev) != hipSuccess || hipDeviceGetAttribute(&cus, hipDeviceAttributeMultiprocessorCount, dev) != hipSuccess) { grid = -1; return; }
        if (hipFuncSetAttribute((const void*)hyb_fwd, hipFuncAttributeMaxDynamicSharedMemorySize, LDS_BYTES) != hipSuccess) { fprintf(stderr, "kernel_launch: hipFuncSetAttribute failed\n"); grid = -1; return; }
        if (hipOccupancyMaxActiveBlocksPerMultiprocessor(&per_cu, (const void*)hyb_fwd, NWAVES * 64, LDS_BYTES) != hipSuccess || per_cu < 1) fprintf(stderr, "kernel_launch: occupancy query says %d\n", per_cu);
        (void)hipGetLastError();
        grid = cus;
    }
    if (grid < 0) return;
    if (hipMemsetAsync((char*)d_ws + WS_CTL, 0, CTL_ZERO_BYTES, stream) != hipSuccess) return;
    Args a{};
    for (int i = 0; i < 23; ++i) a.in[i] = d_in[i];
    a.out = (float*)d_out; a.ws = (unsigned char*)d_ws;
#if MK_ONE_LAUNCH
    a.ph_lo = 0; a.ph_hi = NPH;
    hipLaunchKernelGGL(hyb_fwd, dim3(grid), dim3(NWAVES * 64), LDS_BYTES, stream, a);
#else
    for (int ph = 0; ph < NPH; ++ph) {
        if (ph > 0) { const int fi = (ph - 1) / SLOTS, slot = (ph - 1) % SLOTS; if ((fi & 1) && slot >= 4) continue; }
        a.ph_lo = ph; a.ph_hi = ph + 1;
        hipLaunchKernelGGL(hyb_fwd, dim3(grid), dim3(NWAVES * 64), LDS_BYTES, stream, a);
    }
#endif
}
```

```cpp
#include <hip/hip_runtime.h>
constexpr int NWAVES = 8;
constexpr int BATCH = 16, SEQ = 2048, D = 2048, DEPTH = 4, M = BATCH * SEQ;
constexpr int DFF = 5632, NFI = 2 * DFF;
constexpr int NIN = 7184, NINP = 7424, PW = 7168;
constexpr int FFN_SPLIT = 1;
#ifndef X3_MASK0
#define X3_MASK0 0x1Du
#endif
constexpr int NH = 8;
constexpr float LN_EPS = 1e-5f, SUBLN_EPS = 1e-5f, GN_EPS = 1e-6f, L2_EPS = 1e-6f;
constexpr float ALPHA = 1.681792830507429f;
constexpr float QSCALE = 0.125f * 1.4426950408889634f;
constexpr int NFFN = 2 * DEPTH, SLOTS = 11, NPH = 2 + SLOTS * NFFN;

constexpr size_t MiB = 1u << 20;
constexpr size_t WS_CTL = 0, CTL_ZERO_BYTES = 1 * MiB;
constexpr size_t WS_ROPE = 1 * MiB, WS_BA = 3 * MiB, WS_CD = 5 * MiB, WS_STATS = 5 * MiB + 512 * 1024, WS_CSF = 6 * MiB, WS_BWF = 6 * MiB + 256 * 1024, WS_CSI = 6 * MiB + 512 * 1024, WS_BWI = 6 * MiB + 768 * 1024;
constexpr size_t WS_WFI = 8 * MiB, WS_WFO = 52 * MiB, WS_WIN = 74 * MiB, WS_WOUT = 103 * MiB;
constexpr size_t WS_XB = 112 * MiB, WS_MIX = 240 * MiB, WS_HP = 368 * MiB, WS_GDN = 816 * MiB, WS_O = 1104 * MiB, WS_PS = 1232 * MiB, WS_WFO2 = 1240 * MiB, WS_YLO = 1262 * MiB, WS_END = 1326 * MiB;
static_assert(WS_WFI + (size_t)NFI * D * 2 <= WS_WFO && WS_WFO + (size_t)D * DFF * 2 <= WS_WIN && WS_WIN + (size_t)NINP * D * 2 <= WS_WOUT && WS_WOUT + (size_t)D * D * 2 <= WS_XB, "weights map");
static_assert(WS_XB + (size_t)M * D * 2 <= WS_MIX && WS_MIX + (size_t)M * D * 2 <= WS_HP && WS_HP + (size_t)M * PW * 2 <= WS_GDN && WS_GDN + (size_t)4096 * 73728 <= WS_O && WS_O + (size_t)M * D * 2 <= WS_PS && WS_YLO + (size_t)M * D <= WS_END, "act map");
constexpr int CW_TMO = 0, CW_CODE = 1, CW_BAR = 4096;

constexpr int RING_OFF = 0, RING_BYTES = 131072;
constexpr int LDSCTL_OFF = RING_BYTES, MISC_OFF = LDSCTL_OFF + 320;
constexpr int LDS_BYTES = 147456;
static_assert(MISC_OFF + 128 <= LDS_BYTES, "LDS map");

#define GAS __attribute__((address_space(1)))
#define LAS __attribute__((address_space(3)))
enum { I_X = 0, I_POS, I_F1IN, I_F1OUT, I_LN1G, I_LN1B, I_WIN, I_CONVW, I_ALOG, I_DTB, I_LQ1, I_LK1, I_LQ2, I_LK2, I_DIFFG, I_DELTAG, I_WOUT, I_LN2G, I_LN2B, I_F2IN, I_F2OUT, I_LN3G, I_LN3B, I_OUT, I_WS };
constexpr int PTAB_OFF = LDSCTL_OFF + 512;
__device__ __forceinline__ unsigned char* ptab(int i) {
    extern __shared__ __attribute__((aligned(16))) unsigned char lds[];
    const LAS unsigned* t = (const LAS unsigned*)((LAS unsigned char*)lds + PTAB_OFF) + 2 * i;
    const unsigned lo = __builtin_amdgcn_readfirstlane(t[0]), hi = __builtin_amdgcn_readfirstlane(t[1]);
    return (unsigned char*)(GAS unsigned char*)(((unsigned long long)hi << 32) | lo);
}
constexpr int EPI_OFF = LDSCTL_OFF + 1024;
__device__ __forceinline__ LAS unsigned char* lds_base() { extern __shared__ __attribute__((aligned(16))) unsigned char lds[]; return (LAS unsigned char*)lds; }
__device__ __forceinline__ void epi_tables_dma(const float* stats, const float* ta, const float* tb, int row0, int col0, int wid, int lane) {
    if (wid < 4) { const float* src = wid < 2 ? stats + 2 * (size_t)(row0 + 128 * wid) : (wid == 2 ? ta : tb) + col0;
        __builtin_amdgcn_global_load_lds((const GAS unsigned*)(src + 4 * lane), (LAS unsigned*)(lds_base() + EPI_OFF + wid * 1024), 16, 0, 0); }
}
constexpr float YLO_S = 4096.0f, YLO_IS = 1.0f / 4096.0f;
#include <hip/hip_runtime.h>
#include <cstdio>
#include <cstdint>
namespace pg8 {
#define PG8_LAS __attribute__((address_space(3)))
typedef unsigned short bf16_t;
typedef short bf16x8 __attribute__((ext_vector_type(8)));
typedef float f32x4 __attribute__((ext_vector_type(4)));
typedef unsigned u32x4 __attribute__((ext_vector_type(4)));
constexpr int BM = 256, BK = 64, HALF = 128, HTB = HALF * BK * 2  , STAGE_BYTES = 8 * HTB, NXCD = 8, WGM = 8;

__host__ __device__ __forceinline__ int lds_byte(int r, int c) { const int st = (r >> 4) * 2 + (c >> 5), rr = r & 15, cc = c & 31, ob = rr * 64 + cc * 2; return st * 1024 + (ob ^ (((ob >> 9) & 1) << 5)); }
__host__ __device__ __forceinline__ void stage_rc(int b, int& R, int& C) { const int st = b / 1024, sb = b % 1024, swz = sb ^ (((sb >> 9) & 1) << 5); R = (st >> 1) * 16 + swz / 64; C = (st & 1) * 32 + (swz % 64) / 2; }
__host__ __device__ __forceinline__ int perm32(int rho) { const int n = rho >> 4, i = rho & 15; return 8 * (i >> 2) + 4 * n + (i & 3); }

struct Unit { int pm, pn; };
struct Gemm { const bf16_t* A; const bf16_t* Bt; int M, N, K; };

struct StaticOrder {
    int nM, nN, nwg, G, c;
    __host__ __device__ void init(int M, int N, int G_, int c_) { nM = M / BM; nN = N / BM; nwg = nM * nN; G = G_; c = c_; }
    __host__ __device__ bool next(int i, Unit& u) const {
        const long L = (long)i * G + c; if (L >= nwg) return false;
        int wgid = (int)L; { const int q = nwg / NXCD, r = nwg % NXCD, xcd = wgid % NXCD, off = wgid / NXCD; wgid = (xcd < r ? xcd * (q + 1) : r * (q + 1) + (xcd - r) * q) + off; }
        const int nig = WGM * nN, gid = wgid / nig, fm = gid * WGM, gsz = (nM - fm) < WGM ? (nM - fm) : WGM;
        u.pm = fm + ((wgid % nig) % gsz); u.pn = (wgid % nig) / gsz; return true;
    }
    __device__ __forceinline__ void a_ready(const Unit&) const {}
    __device__ __forceinline__ void done(const Unit&) const {}
};

struct StaticOrderOff : StaticOrder {
    int pm0;
    __host__ __device__ bool next(int i, Unit& u) const { const bool ok = StaticOrder::next(i, u); u.pm += pm0; return ok; }
};

__device__ __forceinline__ unsigned cvt_pk_bf16(float lo, float hi) { unsigned r; asm volatile("v_cvt_pk_bf16_f32 %0, %1, %2" : "=v"(r) : "v"(lo), "v"(hi)); return r; }
typedef float f32x2 __attribute__((ext_vector_type(2)));
__device__ __forceinline__ float silu_f(float g) { return g * __builtin_amdgcn_rcpf(1.0f + __builtin_amdgcn_exp2f(-1.4426950408889634f * g)); }
struct LnFold {
    __device__ __forceinline__ f32x2 st(int rowt) const { return *(const LAS f32x2*)(lds_base() + EPI_OFF + rowt * 8); }
    __device__ __forceinline__ void cols8(int colt, f32x4 (&cs)[2], f32x4 (&bw)[2]) const {
        const LAS unsigned char* p = lds_base() + EPI_OFF + 2048 + colt * 4;
        cs[0] = *(const LAS f32x4*)p; cs[1] = *(const LAS f32x4*)(p + 16); bw[0] = *(const LAS f32x4*)(p + 1024); bw[1] = *(const LAS f32x4*)(p + 1040); }
};
struct EpiSwiGLU {
    static constexpr bool PERM = true, AFTER_DRAIN = false; static constexpr int NSTORE = 8;
    int pad_;
    __device__ __forceinline__ void pre(const Unit& u, int wid, int lane) const { unsigned char* const ws = ptab(I_WS); epi_tables_dma((const float*)(ws + WS_STATS), (const float*)(ws + WS_CSF), (const float*)(ws + WS_BWF), u.pm * BM, u.pn * BM, wid, lane); }
    __device__ __forceinline__ void operator()(const f32x4 (&acc)[2][2][4][2], const Unit& u, int wr, int wc, int fr, int fq) const {
        unsigned char* const ws = ptab(I_WS); bf16_t* const H = (bf16_t*)(ws + WS_HP); constexpr int ldh = DFF; const LnFold F{};
        const int rowt0 = wr * 64 + fr, row0 = u.pm * BM + rowt0, col0 = u.pn * HALF + wc * 32 + 8 * fq, wcol = wc * 32 + 8 * fq;
        f32x4 csg[2], bwg[2], csu[2], bwu[2]; F.cols8(wcol, csg, bwg); F.cols8(wcol + HALF, csu, bwu);
#pragma unroll
        for (int ai = 0; ai < 2; ++ai)
#pragma unroll
            for (int m = 0; m < 4; ++m) { const int row = row0 + ai * HALF + m * 16; bf16_t* rowp = H + (size_t)row * ldh + col0;
                const f32x2 st = F.st(rowt0 + ai * HALF + m * 16); const float mu = st.x, rs = st.y;
                const f32x4 g0 = (acc[ai][0][m][0] - csg[0] * mu) * rs + bwg[0], g1 = (acc[ai][0][m][1] - csg[1] * mu) * rs + bwg[1];
                const f32x4 u0 = (acc[ai][1][m][0] - csu[0] * mu) * rs + bwu[0], u1 = (acc[ai][1][m][1] - csu[1] * mu) * rs + bwu[1];
                u32x4 w; w.x = cvt_pk_bf16(silu_f(g0[0]) * u0[0], silu_f(g0[1]) * u0[1]); w.y = cvt_pk_bf16(silu_f(g0[2]) * u0[2], silu_f(g0[3]) * u0[3]);
                w.z = cvt_pk_bf16(silu_f(g1[0]) * u1[0], silu_f(g1[1]) * u1[1]); w.w = cvt_pk_bf16(silu_f(g1[2]) * u1[2], silu_f(g1[3]) * u1[3]);
                *(u32x4*)rowp = w; }
    }
};
struct EpiResLN {
    static constexpr int NSTORE = 32;
    static constexpr bool PERM = true, AFTER_DRAIN = false;
    int ig, ib, loff; float alpha, s; bool hasln;
    static __device__ __forceinline__ float blo(unsigned w) { return __builtin_bit_cast(float, w << 16); }
    static __device__ __forceinline__ float bhi(unsigned w) { return __builtin_bit_cast(float, w & 0xffff0000u); }
    __device__ __forceinline__ void pre(const Unit& u, int wid, int lane) const { unsigned char* const ws = ptab(I_WS);
        epi_tables_dma((const float*)(ws + WS_STATS), (const float*)ptab(ig) + loff, (const float*)ptab(ib) + loff, u.pm * BM, u.pn * BM, wid, lane); }
    __device__ __forceinline__ void operator()(const f32x4 (&acc)[2][2][4][2], const Unit& u, int wr, int wc, int fr, int fq) const {
        unsigned char* const ws = ptab(I_WS); bf16_t* const YB = (bf16_t*)(ws + WS_XB); unsigned char* const YL = ws + WS_YLO; constexpr int ldc = D;
        float* const PS = (float*)(ws + WS_PS); const LnFold F{};
        const int rowt0 = wr * 64 + fr, row0 = u.pm * BM + rowt0, colt = wc * 32 + 8 * fq, col0 = u.pn * BM + colt;
        typedef unsigned u32x2_t __attribute__((ext_vector_type(2))); typedef float f32x2_t __attribute__((ext_vector_type(2)));
        u32x4 yh[3][2]; u32x2_t yl[3][2];
#define EPI_LOADG(buf, rg_) do { const size_t off_ = (size_t)(row0 + ((rg_) >> 2) * HALF + ((rg_) & 3) * 16) * ldc + col0; \
            _Pragma("unroll") for (int bj = 0; bj < 2; ++bj) { yh[buf][bj] = *(const u32x4*)(YB + off_ + bj * HALF); yl[buf][bj] = *(const u32x2_t*)(YL + off_ + bj * HALF); } } while (0)
        EPI_LOADG(0, 0); EPI_LOADG(1, 1);
#pragma unroll
        for (int rg = 0; rg < 8; ++rg) { const int ai = rg >> 2, m = rg & 3;
            if (rg + 2 < 8) { if ((rg + 2) % 3 == 0) EPI_LOADG(0, rg + 2); else if ((rg + 2) % 3 == 1) EPI_LOADG(1, rg + 2); else EPI_LOADG(2, rg + 2); }
            __builtin_amdgcn_sched_barrier(0);
            { const int row = row0 + ai * HALF + m * 16; const size_t off = (size_t)row * ldc + col0;
                const f32x2 st = F.st(rowt0 + ai * HALF + m * 16); const float mu = st.x, rs = st.y;
                float s1 = 0.f, s2 = 0.f;
#pragma unroll
                for (int bj = 0; bj < 2; ++bj) { f32x4 yn[2]; f32x4 gv[2], bv[2]; F.cols8(colt + bj * HALF, gv, bv);
                    if (!hasln) { gv[0] = (f32x4){1.f, 1.f, 1.f, 1.f}; gv[1] = gv[0]; bv[0] = (f32x4){0.f, 0.f, 0.f, 0.f}; bv[1] = bv[0]; }
#pragma unroll
                    for (int n = 0; n < 2; ++n) { const unsigned h0 = yh[rg % 3][bj][2 * n], h1 = yh[rg % 3][bj][2 * n + 1]; const int lw = (int)yl[rg % 3][bj][n];
                        const f32x2_t p0 = __builtin_amdgcn_cvt_pk_f32_bf8(lw, false), p1 = __builtin_amdgcn_cvt_pk_f32_bf8(lw, true);
                        const f32x4 yold = (f32x4){blo(h0) + p0.x * YLO_IS, bhi(h0) + p0.y * YLO_IS, blo(h1) + p1.x * YLO_IS, bhi(h1) + p1.y * YLO_IS};
                        const f32x4 xo = (yold - mu) * rs * gv[n] + bv[n]; yn[n] = xo * alpha + acc[ai][bj][m][n] * s;
                        s1 += (yn[n][0] + yn[n][1]) + (yn[n][2] + yn[n][3]); s2 += (yn[n][0] * yn[n][0] + yn[n][1] * yn[n][1]) + (yn[n][2] * yn[n][2] + yn[n][3] * yn[n][3]); }
                    u32x4 w; w.x = cvt_pk_bf16(yn[0][0], yn[0][1]); w.y = cvt_pk_bf16(yn[0][2], yn[0][3]); w.z = cvt_pk_bf16(yn[1][0], yn[1][1]); w.w = cvt_pk_bf16(yn[1][2], yn[1][3]);
                    int l0 = __builtin_amdgcn_cvt_pk_bf8_f32((yn[0][0] - blo(w.x)) * YLO_S, (yn[0][1] - bhi(w.x)) * YLO_S, 0, false); l0 = __builtin_amdgcn_cvt_pk_bf8_f32((yn[0][2] - blo(w.y)) * YLO_S, (yn[0][3] - bhi(w.y)) * YLO_S, l0, true);
                    int l1 = __builtin_amdgcn_cvt_pk_bf8_f32((yn[1][0] - blo(w.z)) * YLO_S, (yn[1][1] - bhi(w.z)) * YLO_S, 0, false); l1 = __builtin_amdgcn_cvt_pk_bf8_f32((yn[1][2] - blo(w.w)) * YLO_S, (yn[1][3] - bhi(w.w)) * YLO_S, l1, true);
                    *(u32x4*)(YB + off + bj * HALF) = w; *(u32x2_t*)(YL + off + bj * HALF) = (u32x2_t){(unsigned)l0, (unsigned)l1}; }
                s1 += __shfl_xor(s1, 16); s2 += __shfl_xor(s2, 16); s1 += __shfl_xor(s1, 32); s2 += __shfl_xor(s2, 32);
                if (fq == 0) *(f32x2*)(PS + ((size_t)row * 32 + 4 * u.pn + wc) * 2) = (f32x2){s1, s2}; }
            __builtin_amdgcn_sched_barrier(0);
        }
#undef EPI_LOADG
    }
};
struct EpiInProj {
    static constexpr bool PERM = true, AFTER_DRAIN = false; static constexpr int NSTORE = 16;
    float qscale;
    __device__ __forceinline__ void pre(const Unit& u, int wid, int lane) const { unsigned char* const ws = ptab(I_WS); epi_tables_dma((const float*)(ws + WS_STATS), (const float*)(ws + WS_CSI), (const float*)(ws + WS_BWI), u.pm * BM, u.pn * BM, wid, lane); }
    __device__ __forceinline__ void operator()(const f32x4 (&acc)[2][2][4][2], const Unit& u, int wr, int wc, int fr, int fq) const {
        unsigned char* const ws = ptab(I_WS); bf16_t* const P = (bf16_t*)(ws + WS_HP); constexpr int ldp = PW; const float* const rope = (const float*)(ws + WS_ROPE);
        const LnFold F{};
        const int rowt0 = wr * 64 + fr, row0 = u.pm * BM + rowt0, wct = wc * 32 + 8 * fq, wcol = u.pn * BM + wct;
        const bool rot = (u.pn < 8) && ((wc & 1) == 0) && (fq < 2);
        const float sc = (u.pn < 4) ? qscale : 1.0f;
        f32x4 cs[2][2], bw[2][2]; F.cols8(wct, cs[0], bw[0]); F.cols8(wct + HALF, cs[1], bw[1]);
#pragma unroll
        for (int ai = 0; ai < 2; ++ai)
#pragma unroll
            for (int m = 0; m < 4; ++m) { const int row = row0 + ai * HALF + m * 16; bf16_t* rowp = P + (size_t)row * ldp + wcol;
                const f32x2 st = F.st(rowt0 + ai * HALF + m * 16);
                f32x4 cv = (f32x4){1.f, 1.f, 1.f, 1.f}, sn = (f32x4){0.f, 0.f, 0.f, 0.f};
                if (rot) { cv = *(const f32x4*)(rope + (size_t)row * 16 + 4 * fq); sn = *(const f32x4*)(rope + (size_t)row * 16 + 8 + 4 * fq); }
#pragma unroll
                for (int bj = 0; bj < 2; ++bj) { const f32x4 a = (acc[ai][bj][m][0] - cs[bj][0] * st.x) * st.y + bw[bj][0], b = (acc[ai][bj][m][1] - cs[bj][1] * st.x) * st.y + bw[bj][1];
                    const f32x4 v0 = (a * cv - b * sn) * sc, v1 = (b * cv + a * sn) * sc;
                    u32x4 w; w.x = cvt_pk_bf16(v0[0], v0[1]); w.y = cvt_pk_bf16(v0[2], v0[3]); w.z = cvt_pk_bf16(v1[0], v1[1]); w.w = cvt_pk_bf16(v1[2], v1[3]);
                    *(u32x4*)(rowp + bj * HALF) = w; } }
    }
};
template <class Epi, class Sched, bool ALIGN_EPI = false, bool SP2 = false>
__device__ __forceinline__ void gemm_phase(PG8_LAS unsigned char* lds, const Gemm g, const Sched& S, const Epi& E) {
    int tid_ = threadIdx.x; asm volatile("" : "+v"(tid_));
    const int tid = tid_, wid = __builtin_amdgcn_readfirstlane(tid >> 6), lane = tid & 63, wr = wid >> 2, wc = wid & 3, fr = lane & 15, fq = lane >> 4;
    const int K = g.K, nt = K / BK;
    unsigned voffA[2], voffB[2];
#pragma unroll
    for (int i = 0; i < 2; ++i) { int R, C; stage_rc(tid * 16 + i * 8192, R, C); const int Rb = Epi::PERM ? ((R & ~31) + perm32(R & 31)) : R;
        voffA[i] = (unsigned)(R * K + C) * 2u; voffB[i] = (unsigned)(Rb * K + C) * 2u; }
    const size_t kstep = (size_t)(BK * 2);
    const size_t hstep = (size_t)HALF * K * 2;
    const size_t tstep = 2 * hstep;
    const unsigned ldsw = (unsigned)wid * 1024u;
    const int aoff = lds_byte(wr * 64 + fr, fq * 8), boff = lds_byte(wc * 32 + fr, fq * 8);
#define PG8_SA(b, h) (((b) * 2 + (h)) * HTB)
#define PG8_SB(b, h) ((4 + (b) * 2 + (h)) * HTB)
#define PG8_STAGE(bufoff, gbase, voff) do { _Pragma("unroll") for (int _i = 0; _i < 2; ++_i) \
        __builtin_amdgcn_global_load_lds((const unsigned*)((const char*)(gbase) + (voff)[_i]), (PG8_LAS unsigned*)(lds + (bufoff) + ldsw + _i * 8192), 16, 0, 0); } while (0)
#define PG8_LDA(dst, b, h) do { _Pragma("unroll") for (int m = 0; m < 4; ++m) _Pragma("unroll") for (int k = 0; k < 2; ++k) dst[m][k] = *(const PG8_LAS bf16x8*)(lds + PG8_SA(b, h) + aoff + m * 2048 + k * 1024); } while (0)
#define PG8_LDB(dst, b, h) do { _Pragma("unroll") for (int n = 0; n < 2; ++n) _Pragma("unroll") for (int k = 0; k < 2; ++k) dst[n][k] = *(const PG8_LAS bf16x8*)(lds + PG8_SB(b, h) + boff + n * 2048 + k * 1024); } while (0)
#define PG8_MMA(ai, bj, At, Bt) do { __builtin_amdgcn_s_setprio(1); _Pragma("unroll") for (int m = 0; m < 4; ++m) _Pragma("unroll") for (int n = 0; n < 2; ++n) _Pragma("unroll") for (int k = 0; k < 2; ++k) \
        acc[ai][bj][m][n] = __builtin_amdgcn_mfma_f32_16x16x32_bf16(Bt[n][k], At[m][k], acc[ai][bj][m][n], 0, 0, 0); __builtin_amdgcn_s_setprio(0); } while (0)
#define PG8_WAIT_V(n) asm volatile("s_waitcnt vmcnt(" #n ")" ::: "memory")
#define PG8_WAIT_VX(pe) do { if (pe) asm volatile("s_waitcnt vmcnt(%0)" :: "n"(8 + Epi::NSTORE) : "memory"); else PG8_WAIT_V(8); } while (0)
#define PG8_WAIT_L(n) asm volatile("s_waitcnt lgkmcnt(" #n ")" ::: "memory")
#define PG8_BAR __builtin_amdgcn_s_barrier()
#define PG8_SCHED __builtin_amdgcn_sched_barrier(0)
    Unit cur, nxt; int ui = 0;
    if (!S.next(0, cur)) return;
    f32x4 acc[2][2][4][2];
#pragma unroll
    for (int a = 0; a < 2; ++a)
#pragma unroll
        for (int b = 0; b < 2; ++b)
#pragma unroll
            for (int m = 0; m < 4; ++m)
#pragma unroll
                for (int n = 0; n < 2; ++n) acc[a][b][m][n] = (f32x4){0.f, 0.f, 0.f, 0.f};
    bf16x8 At[4][2], B0[2][2], B1[2][2];
    const char* cA = (const char*)g.A + (size_t)cur.pm * tstep; const char* cB = (const char*)g.Bt + (size_t)cur.pn * tstep;
    S.a_ready(cur);
    if constexpr (SP2) {
        PG8_STAGE(PG8_SB(0, 0), cB, voffB); PG8_STAGE(PG8_SB(0, 1), cB + hstep, voffB); PG8_STAGE(PG8_SA(0, 0), cA, voffA); PG8_STAGE(PG8_SA(0, 1), cA + hstep, voffA);
        if (wr == 1) PG8_BAR;
        PG8_WAIT_V(2); PG8_BAR;
        PG8_STAGE(PG8_SB(1, 0), cB + kstep, voffB); PG8_STAGE(PG8_SA(1, 0), cA + kstep, voffA); PG8_STAGE(PG8_SB(1, 1), cB + hstep + kstep, voffB);
        PG8_WAIT_V(6); PG8_BAR;
    } else {
        PG8_STAGE(PG8_SB(0, 0), cB, voffB); PG8_STAGE(PG8_SA(0, 0), cA, voffA); PG8_STAGE(PG8_SB(0, 1), cB + hstep, voffB); PG8_STAGE(PG8_SA(0, 1), cA + hstep, voffA);
        if (wr == 1) PG8_BAR;
        PG8_WAIT_V(4); PG8_BAR;
        PG8_STAGE(PG8_SB(1, 0), cB + kstep, voffB); PG8_STAGE(PG8_SA(1, 0), cA + kstep, voffA); PG8_STAGE(PG8_SB(1, 1), cB + hstep + kstep, voffB);
        PG8_WAIT_V(6); PG8_BAR;
    }
    for (;;) {
        const bool has_next = S.next(ui + 1, nxt);
        const char* nA = has_next ? (const char*)g.A + (size_t)nxt.pm * tstep : cA; const char* nB = has_next ? (const char*)g.Bt + (size_t)nxt.pn * tstep : cB;
        for (int t = 0; t < nt; t += 2) {
            const bool last = (t == nt - 2);
            const char* a1 = cA + (size_t)(t + 1) * kstep;
            const char* a2 = last ? nA : cA + (size_t)(t + 2) * kstep; const char* b2 = last ? nB : cB + (size_t)(t + 2) * kstep;
            const char* a3 = a2 + kstep; const char* b3 = b2 + kstep;
            if (last && has_next) S.a_ready(nxt);
            int tq_ = t; asm volatile("" : "+s"(tq_));
            const bool pe = SP2 && ALIGN_EPI && tq_ == 0 && ui > 0;
            if (last) E.pre(cur, wid, lane);
            if constexpr (SP2) {
            PG8_LDB(B0, 0, 0); PG8_LDB(B1, 0, 1); PG8_SCHED; PG8_LDA(At, 0, 0); if (!pe) PG8_STAGE(PG8_SA(1, 1), a1 + hstep, voffA);
            PG8_WAIT_VX(pe); PG8_WAIT_L(0); PG8_BAR; PG8_MMA(0, 0, At, B0); PG8_MMA(0, 1, At, B1); PG8_BAR; PG8_SCHED;
            PG8_LDA(At, 0, 1); PG8_STAGE(PG8_SB(0, 0), b2, voffB); PG8_STAGE(PG8_SB(0, 1), b2 + hstep, voffB); PG8_STAGE(PG8_SA(0, 0), a2, voffA);
            PG8_WAIT_VX(pe); PG8_WAIT_L(0); PG8_BAR; PG8_MMA(1, 0, At, B0); PG8_MMA(1, 1, At, B1); PG8_BAR; PG8_SCHED;
            PG8_LDB(B0, 1, 0); PG8_LDB(B1, 1, 1); PG8_SCHED; PG8_LDA(At, 1, 0); PG8_STAGE(PG8_SA(0, 1), a2 + hstep, voffA);
            PG8_WAIT_VX(pe); PG8_WAIT_L(0); PG8_BAR; PG8_MMA(0, 0, At, B0); PG8_MMA(0, 1, At, B1); PG8_BAR; PG8_SCHED;
            PG8_LDA(At, 1, 1); PG8_STAGE(PG8_SB(1, 0), b3, voffB); PG8_STAGE(PG8_SB(1, 1), b3 + hstep, voffB); PG8_STAGE(PG8_SA(1, 0), a3, voffA);
            PG8_WAIT_V(8); PG8_WAIT_L(0); PG8_BAR; PG8_MMA(1, 0, At, B0); PG8_MMA(1, 1, At, B1); PG8_BAR; PG8_SCHED;
            } else {
            PG8_LDB(B0, 0, 0); PG8_SCHED; PG8_LDA(At, 0, 0); PG8_STAGE(PG8_SA(1, 1), a1 + hstep, voffA);
            PG8_WAIT_L(8); PG8_BAR; PG8_WAIT_L(0); PG8_MMA(0, 0, At, B0); PG8_BAR; PG8_SCHED;
            PG8_LDB(B1, 0, 1); PG8_STAGE(PG8_SB(0, 0), b2, voffB);
            PG8_BAR; PG8_WAIT_L(0); PG8_MMA(0, 1, At, B1); PG8_BAR;
            PG8_LDA(At, 0, 1); PG8_STAGE(PG8_SA(0, 0), a2, voffA);
            PG8_BAR; PG8_WAIT_L(0); PG8_MMA(1, 0, At, B0); PG8_BAR; PG8_SCHED;
            PG8_STAGE(PG8_SB(0, 1), b2 + hstep, voffB);
            PG8_WAIT_V(6); PG8_BAR; PG8_MMA(1, 1, At, B1); PG8_BAR;
            PG8_LDB(B0, 1, 0); PG8_SCHED; PG8_LDA(At, 1, 0); PG8_STAGE(PG8_SA(0, 1), a2 + hstep, voffA);
            PG8_WAIT_L(8); PG8_BAR; PG8_WAIT_L(0); PG8_MMA(0, 0, At, B0); PG8_BAR; PG8_SCHED;
            PG8_LDB(B1, 1, 1); PG8_STAGE(PG8_SB(1, 0), b3, voffB);
            PG8_BAR; PG8_WAIT_L(0); PG8_MMA(0, 1, At, B1); PG8_BAR;
            PG8_LDA(At, 1, 1); PG8_STAGE(PG8_SA(1, 0), a3, voffA);
            PG8_BAR; PG8_WAIT_L(0); PG8_MMA(1, 0, At, B0); PG8_BAR; PG8_SCHED;
            PG8_STAGE(PG8_SB(1, 1), b3 + hstep, voffB);
            PG8_WAIT_V(6); PG8_BAR; PG8_MMA(1, 1, At, B1); PG8_BAR;
            }
        }
        if constexpr (ALIGN_EPI) { if (wr == 0) PG8_BAR; }
        if constexpr (SP2 && ALIGN_EPI) { if (has_next) PG8_STAGE(PG8_SA(1, 1), nA + kstep + hstep, voffA); }
        if constexpr (!Epi::AFTER_DRAIN) { E(acc, cur, wr, wc, fr, fq); S.done(cur); }
        if (!has_next) break;
#pragma unroll
        for (int a = 0; a < 2; ++a)
#pragma unroll
            for (int b = 0; b < 2; ++b)
#pragma unroll
                for (int m = 0; m < 4; ++m)
#pragma unroll
                    for (int n = 0; n < 2; ++n) acc[a][b][m][n] = (f32x4){0.f, 0.f, 0.f, 0.f};
        cur = nxt; cA = nA; cB = nB; ++ui;
        if constexpr (ALIGN_EPI) { if (wr == 1) PG8_BAR; }
    }
    PG8_WAIT_V(0);
    if constexpr (!ALIGN_EPI) { if (wr == 0) PG8_BAR; }
    PG8_BAR;
    if constexpr (Epi::AFTER_DRAIN) { E.fused(acc, cur, wr, wc, fr, fq, lds, wid, lane); S.done(cur); }
#undef PG8_SA
#undef PG8_SB
#undef PG8_STAGE
#undef PG8_LDA
#undef PG8_LDB
#undef PG8_MMA
#undef PG8_WAIT_V
#undef PG8_WAIT_L
#undef PG8_BAR
#undef PG8_SCHED
}
}

#ifndef PG8_SP2
#define PG8_SP2 true
#endif
#ifndef PG8_ALIGN
#define PG8_ALIGN true
#endif
#include <hip/hip_bf16.h>
#include <cmath>
namespace attn_body {
using bf16=__hip_bfloat16;
using bf16x8=__attribute__((ext_vector_type(8)))short;
using s16x4=__attribute__((ext_vector_type(4)))short;
using f32x16=__attribute__((ext_vector_type(16)))float;
using u32x4=__attribute__((ext_vector_type(4)))unsigned;
constexpr int SEQ=2048,D=64,QKVP=7168,OPITCH=2048;
constexpr int NW=8,QBLK=32,QB=QBLK*NW,KVBLK=64,NQB=SEQ/QB;
constexpr int ATTN_UNIT_ROWS=QB;
__device__ __forceinline__ int crow(int r,int hi){return (r&3)+8*(r>>2)+4*hi;}
#define SBAR() __builtin_amdgcn_sched_barrier(0)
__device__ __forceinline__ void cmask(f32x16&p0,f32x16&p1,int jb,int qrel,int hi){
  const float NEG=-INFINITY; int kb=64*jb+4*hi;
  #pragma unroll
  for(int r=0;r<16;++r){int kv=kb+(r&3)+8*(r>>2); if(kv>qrel)p0[r]=NEG; if(kv+32>qrel)p1[r]=NEG;}
}

constexpr int NSLOT=3, SLOTB=8192;
constexpr int LDS_K=0, LDS_V=NSLOT*SLOTB, LDS_WS=3*NSLOT*SLOTB, LDS_OST=LDS_WS+NW*64*4, LDS_BYTES=LDS_OST+NW*4096;
constexpr float C2=0.125f*1.4426950408889634f;
__device__ __forceinline__ void glds16(const void*gsrc,unsigned lds_dst){unsigned keep;
  asm volatile("s_mov_b32 %0, m0\n\ts_mov_b32 m0, %2\n\ts_nop 0\n\tglobal_load_lds_dwordx4 %1, off\n\ts_mov_b32 m0, %0":"=&s"(keep):"v"(gsrc),"s"(lds_dst):"memory");}
__device__ __forceinline__ float max3f(float a,float b,float c){float r;asm("v_max3_f32 %0, %1, %2, %3":"=v"(r):"v"(a),"v"(b),"v"(c));return r;}
__device__ __forceinline__ float max2f(float a,float b){float r;asm("v_max_f32_e32 %0, %1, %2":"=v"(r):"v"(a),"v"(b));return r;}
__device__ __forceinline__ float fadd_s(float a,float b){float r;asm("v_add_f32_e32 %0, %1, %2":"=v"(r):"v"(a),"v"(b));return r;}
__device__ __forceinline__ float fsub_s(float a,float b){float r;asm("v_sub_f32_e32 %0, %1, %2":"=v"(r):"v"(a),"v"(b));return r;}
typedef float f32x2_t __attribute__((ext_vector_type(2))); typedef __bf16 bf16x2_t __attribute__((ext_vector_type(2)));
__device__ __forceinline__ unsigned cvtpk_s(float lo,float hi){f32x2_t v={lo,hi};bf16x2_t b=__builtin_convertvector(v,bf16x2_t);return __builtin_bit_cast(unsigned,b);}
#define WAIT_BAR(N) asm volatile("s_waitcnt vmcnt(" #N ") lgkmcnt(0)\n\ts_barrier":::"memory")

__device__ __forceinline__ void qkt(f32x16&p0,f32x16&p1,const char*Kslot,const bf16x8*qr,const f32x16&negm,int r32,int hi){
  const char*kb=Kslot+hi*1024+r32*16;
  #pragma unroll
  for(int d0=0;d0<4;++d0){
    const bf16x8 b0=*reinterpret_cast<const bf16x8*>(kb+d0*2048);
    const bf16x8 b1=*reinterpret_cast<const bf16x8*>(kb+d0*2048+512);
    if(d0==0){p0=__builtin_amdgcn_mfma_f32_32x32x16_bf16(b0,qr[0],negm,0,0,0);p1=__builtin_amdgcn_mfma_f32_32x32x16_bf16(b1,qr[0],negm,0,0,0);}
    else{p0=__builtin_amdgcn_mfma_f32_32x32x16_bf16(b0,qr[d0],p0,0,0,0);p1=__builtin_amdgcn_mfma_f32_32x32x16_bf16(b1,qr[d0],p1,0,0,0);}}
}
typedef __attribute__((address_space(3))) const char* lds_cptr;
typedef short v4i16_t __attribute__((ext_vector_type(4)));
__device__ __forceinline__ void kload8(bf16x8*kf,lds_cptr kp){
  kf[0]=*(const __attribute__((address_space(3))) bf16x8*)(kp);      kf[1]=*(const __attribute__((address_space(3))) bf16x8*)(kp+512);
  kf[2]=*(const __attribute__((address_space(3))) bf16x8*)(kp+2048); kf[3]=*(const __attribute__((address_space(3))) bf16x8*)(kp+2560);
  kf[4]=*(const __attribute__((address_space(3))) bf16x8*)(kp+4096); kf[5]=*(const __attribute__((address_space(3))) bf16x8*)(kp+4608);
  kf[6]=*(const __attribute__((address_space(3))) bf16x8*)(kp+6144); kf[7]=*(const __attribute__((address_space(3))) bf16x8*)(kp+6656);
}
__device__ __forceinline__ void kload2(bf16x8*kf,lds_cptr kp,int j){ kf[2*j]=*(const __attribute__((address_space(3))) bf16x8*)(kp+j*2048); kf[2*j+1]=*(const __attribute__((address_space(3))) bf16x8*)(kp+j*2048+512); }
__device__ __forceinline__ s16x4 vtr(lds_cptr p){ return __builtin_bit_cast(s16x4,__builtin_amdgcn_ds_read_tr16_b64_v4i16((__attribute__((address_space(3))) v4i16_t*)p)); }
__device__ __forceinline__ float rowmax(const f32x16&p0,const f32x16&p1){
  float a=max3f(p0[0],p0[1],p1[0]),b=max3f(p0[2],p0[3],p1[1]);a=max3f(a,p1[2],p1[3]);
  #pragma unroll
  for(int r=4;r<16;r+=4){a=max3f(a,p0[r],p0[r+1]);b=max3f(b,p0[r+2],p0[r+3]);a=max3f(a,p1[r],p1[r+1]);b=max3f(b,p1[r+2],p1[r+3]);}
  const float m=max2f(a,b);
  auto rr=__builtin_amdgcn_permlane32_swap(__float_as_uint(m),__float_as_uint(m),false,false);
  return max2f(__uint_as_float(rr[0]),__uint_as_float(rr[1]));
}
__device__ __forceinline__ void pv(f32x16*o,int vb,bf16x8 pa0,bf16x8 pa1,bf16x8 pa2,bf16x8 pa3){
  #pragma unroll
  for(int d0=0;d0<4;++d0){s16x4 lo[4],hi[4];
    #pragma unroll
    for(int ks=0;ks<4;++ks){
      asm volatile("ds_read_b64_tr_b16 %0,%1 offset:%c2":"=&v"(lo[ks]):"v"(vb),"i"(d0*4096+ks*1024):"memory");
      asm volatile("ds_read_b64_tr_b16 %0,%1 offset:%c2":"=&v"(hi[ks]):"v"(vb),"i"(d0*4096+ks*1024+512):"memory");}
    asm volatile("s_waitcnt lgkmcnt(0)":::"memory");SBAR();
    #define PK(k) (bf16x8){lo[k][0],lo[k][1],lo[k][2],lo[k][3],hi[k][0],hi[k][1],hi[k][2],hi[k][3]}
    o[d0]=__builtin_amdgcn_mfma_f32_32x32x16_bf16(pa0,PK(0),o[d0],0,0,0);
    o[d0]=__builtin_amdgcn_mfma_f32_32x32x16_bf16(pa1,PK(1),o[d0],0,0,0);
    o[d0]=__builtin_amdgcn_mfma_f32_32x32x16_bf16(pa2,PK(2),o[d0],0,0,0);
    o[d0]=__builtin_amdgcn_mfma_f32_32x32x16_bf16(pa3,PK(3),o[d0],0,0,0);
    #undef PK
  }
}

#ifndef ATTN_STORE16
#define ATTN_STORE16(p,v) (*(u32x4*)(p)=(v))
#endif
template<int THRL> __device__ __forceinline__ void attn_unit(int b,int h,int qb,const bf16*Q,const bf16*__restrict__ K,const bf16*__restrict__ V,bf16*O,char*shm,int mode,const bf16*O1,bf16*MIXp,const float*dg,float lam,float oml,float sub_eps){
  int tid_=threadIdx.x; asm volatile("":"+v"(tid_)); const int tid=tid_,lane=tid&63,r32=lane&31,hi=lane>>5; const int wid=__builtin_amdgcn_readfirstlane(tid>>6);
  const long rowbase=(long)b*SEQ; const int q0=qb*QB;
  const bf16*Qw=Q+(rowbase+q0+wid*QBLK)*QKVP;
  const bf16*Kh=K+rowbase*QKVP,*Vh=V+rowbase*QKVP;
  const unsigned lds0=(unsigned)(uintptr_t)shm;
  float*wsf=(float*)(shm+LDS_WS)+wid*64;
  const bf16*ksrc=Kh+(long)lane*QKVP+wid*8;
  const bf16*vsrc=Vh+(long)(16*(wid&3)+(lane>>2))*QKVP+(wid>>2)*32+(lane&3)*8;
  const unsigned kdst=lds0+LDS_K+wid*1024, vdst=lds0+LDS_V+wid*1024;
  #define DMA_K(t,slot) glds16(ksrc+(long)(t)*KVBLK*QKVP,(unsigned)__builtin_amdgcn_readfirstlane(kdst+(slot)))
  #define DMA_V(t,slot) do{ glds16(vsrc+(long)(t)*KVBLK*QKVP,(unsigned)__builtin_amdgcn_readfirstlane(vdst+2*(slot))); glds16(vsrc+(long)(t)*KVBLK*QKVP+64,(unsigned)__builtin_amdgcn_readfirstlane(vdst+2*(slot)+8192)); }while(0)
  const int vb0=(int)(lds0+LDS_V)+((lane>>4)&1)*32+(lane&3)*8+(4*hi+((lane&15)>>2))*64;
  const char*Kbase=shm+LDS_K; bf16x8 kf[8];
  const lds_cptr shm3=(lds_cptr)shm; const lds_cptr kp0=shm3+LDS_K+hi*1024+r32*16; const lds_cptr vp0=shm3+LDS_V+((lane>>4)&1)*32+(lane&3)*8+(4*hi+((lane&15)>>2))*64;
  const int NT=(q0+QB)/KVBLK;
  DMA_K(0,0);DMA_V(0,0);DMA_K(1,SLOTB);
  bf16x8 qr[4];
  #pragma unroll
  for(int d0=0;d0<4;++d0)qr[d0]=*reinterpret_cast<const bf16x8*>(&Qw[(long)r32*QKVP+d0*16+hi*8]);
  float mhat=0.f,l_reg=0.f;f32x16 o[4];o[0]=f32x16{};o[1]=f32x16{};o[2]=f32x16{};o[3]=f32x16{};f32x16 negm=f32x16{};asm volatile("":"+v"(negm));
  const int qrel=wid*QBLK+r32;
  #define CMASK(P0,P1,t) do{int jb_=(t)-(NT-4); if(jb_>=0)cmask(P0,P1,jb_,qrel,hi);}while(0)
  bool resc=false;
  #define START(P0,P1) do{ const float rm=rowmax(P0,P1); resc=false; \
    { const float dl=rm; mhat=fadd_s(mhat,dl); \
      _Pragma("unroll") for(int r=0;r<16;++r){P0[r]=fsub_s(P0[r],dl);P1[r]=fsub_s(P1[r],dl);} \
      _Pragma("unroll") for(int r=0;r<16;++r)negm[r]=-mhat; asm volatile("":"+v"(negm)); } \
    _Pragma("unroll") for(int r=0;r<16;++r)P0[r]=__builtin_amdgcn_exp2f(P0[r]); }while(0)
  #define RESC() do{ if(resc){ asm volatile("s_waitcnt lgkmcnt(0)":::"memory"); \
      _Pragma("unroll") for(int d_=0;d_<4;++d_) _Pragma("unroll") for(int r=0;r<16;++r)o[d_][r]*=wsf[crow(r,hi)]; } }while(0)
  f32x16 pA0,pA1,pB0,pB1;
  int sl_prev=0,sl_cur=0,sl_next=SLOTB;
  #define ROT() do{sl_prev=sl_cur;sl_cur=sl_next;sl_next=(sl_next==(NSLOT-1)*SLOTB)?0:sl_next+SLOTB;}while(0)
  DMA_K(2,2*SLOTB);
  WAIT_BAR(3);
  qkt(pA0,pA1,Kbase,qr,negm,r32,hi);asm volatile("s_nop 15\n\ts_nop 7":"+v"(pA0),"+v"(pA1));CMASK(pA0,pA1,0);
  START(pA0,pA1);
  _Pragma("unroll") for(int r=0;r<16;++r)pA1[r]=__builtin_amdgcn_exp2f(pA1[r]);
  WAIT_BAR(0);
  DMA_K(3,0);DMA_V(1,SLOTB);
  ROT();
  kload8(kf,kp0+sl_cur);
  WAIT_BAR(3);
  s16x4 vlo[4],vhi[4]; u32x4 pw0,pw1,pw2,pw3;
  #define PKW(P,B) cvtpk_s(P[B],P[B+1])
  #define PAF(k) __builtin_bit_cast(bf16x8,pw##k)
  #define VFR(i) (bf16x8){vlo[(i)&3][0],vlo[(i)&3][1],vlo[(i)&3][2],vlo[(i)&3][3],vhi[(i)&3][0],vhi[(i)&3][1],vhi[(i)&3][2],vhi[(i)&3][3]}
  #define PIN(x) asm volatile("":"+v"(x))
  #define MX3(a,b,c) __builtin_fmaxf(__builtin_fmaxf((a),(b)),(c))
  #define GAPA(MF,A0,A1,A2,A3,W0,W1,PW) do{ MF; sacc+=A0; sacc+=A1; sacc+=A2; sacc+=A3; PIN(sacc); W0; W1; PIN(PW); SBAR(); }while(0)
  #define EX(v) __builtin_amdgcn_exp2f(v)
  #define VRD(n) do{ vlo[(n)&3]=vtr(vp_+(((n)&3)*4096+((n)>>2)*1024)); vhi[(n)&3]=vtr(vp_+(((n)&3)*4096+((n)>>2)*1024+512)); }while(0)
  #define GAPB(n,KS,X,B) do{ o[(n)&3]=__builtin_amdgcn_mfma_f32_32x32x16_bf16(PAF(KS),VFR(n),o[(n)&3],0,0,0); if((n)+4<16){VRD((n)+4);} X[B]=EX(X[B]); X[B+1]=EX(X[B+1]); PIN(X); SBAR(); }while(0)
  #define KRD(G,j) do{ if(G){ kload2(kf,kp0+sl_next,j); SBAR(); } }while(0)
  #define STEP(C0,C1,P0,P1,t,GK,GV,GL) do{ SBAR(); \
    const lds_cptr vp_=vp0+2*sl_prev; \
    float sacc=(P0[0]+P0[1]); \
    GAPA(C0=__builtin_amdgcn_mfma_f32_32x32x16_bf16(kf[0],qr[0],negm,0,0,0), P0[2],P0[3],P0[4],P0[5],     pw0[0]=PKW(P0,0), pw0[1]=PKW(P0,2), pw0); \
    GAPA(C1=__builtin_amdgcn_mfma_f32_32x32x16_bf16(kf[1],qr[0],negm,0,0,0), P0[6],P0[7],P0[8],P0[9],     pw0[2]=PKW(P0,4), pw0[3]=PKW(P0,6), pw0); \
    GAPA(C0=__builtin_amdgcn_mfma_f32_32x32x16_bf16(kf[2],qr[1],C0,0,0,0),   P0[10],P0[11],P0[12],P0[13], pw1[0]=PKW(P0,8), pw1[1]=PKW(P0,10), pw1); \
    GAPA(C1=__builtin_amdgcn_mfma_f32_32x32x16_bf16(kf[3],qr[1],C1,0,0,0),   P0[14],P0[15],P1[0],P1[1],   pw1[2]=PKW(P0,12),pw1[3]=PKW(P0,14), pw1); \
    VRD(0); SBAR(); GAPA(C0=__builtin_amdgcn_mfma_f32_32x32x16_bf16(kf[4],qr[2],C0,0,0,0),   P1[2],P1[3],P1[4],P1[5],     pw2[0]=PKW(P1,0), pw2[1]=PKW(P1,2), pw2); \
    VRD(1); SBAR(); GAPA(C1=__builtin_amdgcn_mfma_f32_32x32x16_bf16(kf[5],qr[2],C1,0,0,0),   P1[6],P1[7],P1[8],P1[9],     pw2[2]=PKW(P1,4), pw2[3]=PKW(P1,6), pw2); \
    VRD(2); SBAR(); GAPA(C0=__builtin_amdgcn_mfma_f32_32x32x16_bf16(kf[6],qr[3],C0,0,0,0),   P1[10],P1[11],P1[12],P1[13], pw3[0]=PKW(P1,8), pw3[1]=PKW(P1,10), pw3); \
    VRD(3); SBAR(); GAPA(C1=__builtin_amdgcn_mfma_f32_32x32x16_bf16(kf[7],qr[3],C1,0,0,0),   P1[14],P1[15],0.f,0.f,       pw3[2]=PKW(P1,12),pw3[3]=PKW(P1,14), pw3); \
    l_reg+=sacc; \
    if(GK){DMA_K((t)+3,sl_cur);} if(GV){DMA_V((t)+1,sl_next);} \
    CMASK(C0,C1,t); \
    { float a=MX3(C0[0],C0[1],C1[0]),b=MX3(C0[2],C0[3],C1[1]); a=MX3(a,C1[2],C1[3]); \
      _Pragma("unroll") for(int r=4;r<16;r+=4){a=MX3(a,C0[r],C0[r+1]);b=MX3(b,C0[r+2],C0[r+3]);a=MX3(a,C1[r],C1[r+1]);b=MX3(b,C1[r+2],C1[r+3]);} \
      float rm=__builtin_fmaxf(a,b); { auto rr=__builtin_amdgcn_permlane32_swap(__float_as_uint(rm),__float_as_uint(rm),false,false); rm=__builtin_fmaxf(__uint_as_float(rr[0]),__uint_as_float(rr[1])); } \
      resc=false; \
      if(__builtin_expect(__any(rm>(float)THRL),0)){ const float dl=__builtin_fmaxf(rm,0.f); mhat+=dl; \
        _Pragma("unroll") for(int r=0;r<16;++r){C0[r]-=dl;C1[r]-=dl;} \
        _Pragma("unroll") for(int r=0;r<16;++r)negm[r]=-mhat; asm volatile("":"+v"(negm)); \
        const float f=__builtin_amdgcn_exp2f(-dl); l_reg*=f; if(hi==0)wsf[r32]=f; resc=true; } } \
    SBAR(); \
    GAPB(0,0,C0,0);  GAPB(1,0,C0,2);  GAPB(2,0,C0,4);   GAPB(3,0,C0,6); \
    GAPB(4,1,C0,8);  GAPB(5,1,C0,10); GAPB(6,1,C0,12);  GAPB(7,1,C0,14); \
    KRD(GL,0); GAPB(8,2,C1,0);  KRD(GL,1); GAPB(9,2,C1,2);  KRD(GL,2); GAPB(10,2,C1,4);  KRD(GL,3); GAPB(11,2,C1,6); \
    GAPB(12,3,C1,8); GAPB(13,3,C1,10); GAPB(14,3,C1,12); GAPB(15,3,C1,14); \
    }while(0)
  int t=1;
  #undef CMASK
  #define CMASK(P0,P1,t) do{}while(0)
  for(;t+5<NT;t+=2){
    STEP(pB0,pB1,pA0,pA1,t,true,true,true);     WAIT_BAR(3); RESC(); ROT();
    STEP(pA0,pA1,pB0,pB1,t+1,true,true,true);   WAIT_BAR(3); RESC(); ROT();
  }
  #undef CMASK
  #define CMASK(P0,P1,t) do{int jb_=(t)-(NT-4); if(jb_>=0)cmask(P0,P1,jb_,qrel,hi);}while(0)
  #define ENDW(tt) do{ if((tt)+3<NT){WAIT_BAR(3);} else if((tt)+2<NT){WAIT_BAR(2);} else {WAIT_BAR(0);} }while(0)
  for(;t+1<NT;t+=2){
    STEP(pB0,pB1,pA0,pA1,t,(t+3<NT),(t+1<NT),(t+1<NT));       ENDW(t);   RESC(); ROT();
    STEP(pA0,pA1,pB0,pB1,t+1,(t+4<NT),(t+2<NT),(t+2<NT));     ENDW(t+1); RESC(); ROT();
  }
  STEP(pB0,pB1,pA0,pA1,NT-1,false,false,false); RESC();
  { float sacc=pB0[0]+pB0[1]; _Pragma("unroll") for(int r=2;r<16;++r)sacc+=pB0[r]; _Pragma("unroll") for(int r=0;r<16;++r)sacc+=pB1[r]; l_reg+=sacc;
    pw0=(u32x4){PKW(pB0,0),PKW(pB0,2),PKW(pB0,4),PKW(pB0,6)};pw1=(u32x4){PKW(pB0,8),PKW(pB0,10),PKW(pB0,12),PKW(pB0,14)};pw2=(u32x4){PKW(pB1,0),PKW(pB1,2),PKW(pB1,4),PKW(pB1,6)};pw3=(u32x4){PKW(pB1,8),PKW(pB1,10),PKW(pB1,12),PKW(pB1,14)};
    SBAR(); pv(o,vb0+2*sl_cur,PAF(0),PAF(1),PAF(2),PAF(3)); }
  #undef PKW
  #undef PAF
  #undef VFR
  #undef PIN
  #undef MX3
  #undef GAPA
  #undef GAPB
  #undef EX
  #undef VRD
  #undef KRD
  #undef STEP
  #undef ENDW
  {auto rr=__builtin_amdgcn_permlane32_swap(__float_as_uint(l_reg),__float_as_uint(l_reg),false,false);l_reg=__uint_as_float(rr[0])+__uint_as_float(rr[1]);}
  if(hi==0)wsf[32+r32]=l_reg;asm volatile("s_waitcnt lgkmcnt(0)":::"memory");
  float rli[16];
  #pragma unroll
  for(int r=0;r<16;++r)rli[r]=__builtin_amdgcn_rcpf(wsf[32+crow(r,hi)]);
  { bf16*stg=(bf16*)(shm+LDS_OST)+wid*2048;
    const long wrow=(rowbase+q0+wid*QBLK)*OPITCH;
    #define ATTN_STAGE(hp) do{ _Pragma("unroll") for(int r=0;r<16;++r){const int orow=crow(r,hi); \
        _Pragma("unroll") for(int d0=0;d0<2;++d0)stg[orow*64+d0*32+r32]=__float2bfloat16(o[2*(hp)+d0][r]*rli[r]);} \
      asm volatile("s_waitcnt lgkmcnt(0)":::"memory"); }while(0)
    if(mode==0){ bf16*Ow=O+wrow;
      #pragma unroll
      for(int hp=0;hp<2;++hp){ ATTN_STAGE(hp);
        #pragma unroll
        for(int i=0;i<4;++i){const int row=i*8+(lane>>3),ch=lane&7; const u32x4 v=*(const u32x4*)(stg+row*64+ch*8); ATTN_STORE16(Ow+(long)row*OPITCH+hp*64+ch*8,v);}
        asm volatile("s_waitcnt lgkmcnt(0)":::"memory"); }
    } else { const bf16*O1w=O1+wrow; bf16*Mw=MIXp+wrow; const int ch=lane&7;
      float dv[2][4][8]; float ss[4]={0.f,0.f,0.f,0.f};
      #define BLO(w_) __uint_as_float((w_)<<16)
      #define BHI(w_) __uint_as_float((w_)&0xffff0000u)
      #pragma unroll
      for(int hp=0;hp<2;++hp){ ATTN_STAGE(hp);
        #pragma unroll
        for(int i=0;i<4;++i){const int row=i*8+(lane>>3); const u32x4 v=*(const u32x4*)(stg+row*64+ch*8); const u32x4 a1=*(const u32x4*)(O1w+(long)row*OPITCH+hp*64+ch*8);
          dv[hp][i][0]=BLO(a1[0])-lam*BLO(v[0]); dv[hp][i][1]=BHI(a1[0])-lam*BHI(v[0]); dv[hp][i][2]=BLO(a1[1])-lam*BLO(v[1]); dv[hp][i][3]=BHI(a1[1])-lam*BHI(v[1]);
          dv[hp][i][4]=BLO(a1[2])-lam*BLO(v[2]); dv[hp][i][5]=BHI(a1[2])-lam*BHI(v[2]); dv[hp][i][6]=BLO(a1[3])-lam*BLO(v[3]); dv[hp][i][7]=BHI(a1[3])-lam*BHI(v[3]);
          #pragma unroll
          for(int e=0;e<8;++e)ss[i]+=dv[hp][i][e]*dv[hp][i][e]; }
        asm volatile("s_waitcnt lgkmcnt(0)":::"memory"); }
      #undef BLO
      #undef BHI
      #pragma unroll
      for(int i=0;i<4;++i){ ss[i]+=__shfl_xor(ss[i],1); ss[i]+=__shfl_xor(ss[i],2); ss[i]+=__shfl_xor(ss[i],4); ss[i]=1.0f/sqrtf(ss[i]*(1.f/128.f)+sub_eps); }
      #pragma unroll
      for(int hp=0;hp<2;++hp){ float g[8];
        #pragma unroll
        for(int e=0;e<8;++e)g[e]=dg[hp*64+ch*8+e]*oml;
        #pragma unroll
        for(int i=0;i<4;++i){const int row=i*8+(lane>>3); const float rn=ss[i]; u32x4 w;
          w[0]=cvtpk_s(dv[hp][i][0]*rn*g[0],dv[hp][i][1]*rn*g[1]); w[1]=cvtpk_s(dv[hp][i][2]*rn*g[2],dv[hp][i][3]*rn*g[3]); w[2]=cvtpk_s(dv[hp][i][4]*rn*g[4],dv[hp][i][5]*rn*g[5]); w[3]=cvtpk_s(dv[hp][i][6]*rn*g[6],dv[hp][i][7]*rn*g[7]);
          ATTN_STORE16(Mw+(long)row*OPITCH+hp*64+ch*8,w);} } }
    #undef ATTN_STAGE
  }
  asm volatile("s_waitcnt lgkmcnt(0)\n\ts_barrier":::"memory");
  #undef DMA_K
  #undef DMA_V
  #undef CMASK
  #undef START
  #undef RESC
  #undef ROT
}
constexpr int ATTN_LDS_BYTES=LDS_BYTES;
template<int THRL=8> __device__ __forceinline__ void attn_head_blocks(char*lds,const bf16*P,bf16*O1,bf16*MIX,const float*dg,float lam,float oml,float sub_eps,int b,int h,unsigned qbmask){
  for(int qb=7;qb>=0;--qb){ if(!((qbmask>>qb)&1u))continue;
    #pragma unroll 1
    for(int c=0;c<2;++c)
      attn_unit<THRL>(b,0,qb,P+(h*2+c)*64,P+1024+(h*2+c)*64,P+2048+h*128,O1+(h*2)*128,lds,c,O1+(h*2)*128,MIX+h*128,dg,lam,oml,sub_eps); }
}
#undef SBAR
#undef WAIT_BAR
}
#define GAS __attribute__((address_space(1)))
#define LAS __attribute__((address_space(3)))
typedef unsigned short bf16;
typedef unsigned v4u __attribute__((ext_vector_type(4)));
typedef float f32x4 __attribute__((ext_vector_type(4)));
typedef short bf16x8 __attribute__((ext_vector_type(8)));
typedef GAS unsigned gu32;
typedef GAS unsigned long long gu64;
#define RLX_AGENT __ATOMIC_RELAXED, __HIP_MEMORY_SCOPE_AGENT
#define LDS_WAIT() asm volatile("s_waitcnt lgkmcnt(0)" ::: "memory")
#define VM_WAIT() asm volatile("s_waitcnt vmcnt(0)" ::: "memory")
__device__ __forceinline__ unsigned long long rt() { return __builtin_amdgcn_s_memrealtime(); }
__device__ __forceinline__ unsigned f2bf(float f) { unsigned u = __builtin_bit_cast(unsigned, f); return (u + 0x7fffu + ((u >> 16) & 1u)) >> 16; }
__device__ __forceinline__ unsigned pk2(float lo, float hi) { return f2bf(lo) | (f2bf(hi) << 16); }

#define XB_TMO      128
#define XB_XCNT(j)  (256  + 64 * (j))
#define XB_XSUB(j)  (1280 + 64 * (j))
#define XB_XGEN(j)  (2304 + 64 * (j))
#define XB_TOP      3328
#define XB_TOPGEN   3392
#define XCD_BAR_WORDS 3456
#define XB_SPIN_CAP (1u << 18)

__device__ __forceinline__ unsigned xb_ld(unsigned* p)              { return __hip_atomic_load(p, __ATOMIC_RELAXED, __HIP_MEMORY_SCOPE_AGENT); }
__device__ __forceinline__ unsigned xb_add(unsigned* p, unsigned v) { return __hip_atomic_fetch_add(p, v, __ATOMIC_RELAXED, __HIP_MEMORY_SCOPE_AGENT); }
__device__ __forceinline__ unsigned xb_xcc_id() { return (unsigned)__builtin_amdgcn_s_getreg((3 << 11) | 20) & 0xFu; }
#define XB_SPIN(cond, bar) do { unsigned _sp = 0; while (cond) { __builtin_amdgcn_s_sleep(1); \
    if ((++_sp & 255u) == 0u) { if (xb_ld(&(bar)[XB_TMO])) break; if (_sp > XB_SPIN_CAP) { atomicAdd(&(bar)[XB_TMO], 1u); break; } } } } while (0)

struct XcdBarrier {
    unsigned* bar; unsigned x;
    volatile LAS unsigned* st;
};

__device__ __forceinline__ XcdBarrier xcd_barrier_post(unsigned* bar, volatile LAS unsigned* st) {
    XcdBarrier b; b.bar = bar; b.x = xb_xcc_id(); b.st = st;
    if (threadIdx.x == 0) (void)xb_add(&bar[XB_XCNT(b.x)], 1u);
    return b;
}
__device__ __forceinline__ void xcd_barrier_complete(unsigned* bar, unsigned x, unsigned& nloc, unsigned& nx) {
    const unsigned G = gridDim.x * gridDim.y * gridDim.z;
    unsigned sum, cnt, mine, sp = 0u;
    for (;;) {
        sum = 0u; cnt = 0u; mine = 0u;
#pragma unroll
        for (unsigned j = 0; j < 16; ++j) { const unsigned c = xb_ld(&bar[XB_XCNT(j)]); sum += c; cnt += (c > 0u) ? 1u : 0u; mine = (j == x) ? c : mine; }
        if (sum == G) break;
        __builtin_amdgcn_s_sleep(1);
        if ((++sp & 255u) == 0u) { if (xb_ld(&bar[XB_TMO])) break; if (sp > XB_SPIN_CAP) { atomicAdd(&bar[XB_TMO], 1u); break; } }
    }
    nloc = mine > 0u ? mine : 1u; nx = cnt > 0u ? cnt : 1u;
}

__device__ __forceinline__ void xcd_barrier(const XcdBarrier& b) {
    asm volatile("s_waitcnt vmcnt(0)" ::: "memory");
    __syncthreads();
    if (threadIdx.x == 0) {
        unsigned* bar = b.bar;
        __builtin_amdgcn_s_waitcnt(0);
        unsigned nloc = b.st[0], nx = b.st[1];
        if (nloc == 0u) { xcd_barrier_complete(bar, b.x, nloc, nx); b.st[0] = nloc; b.st[1] = nx; }
        const unsigned old = xb_add(&bar[XB_XSUB(b.x)], 1u);
        const unsigned gen = old / nloc;
        if (old + 1u == (gen + 1u) * nloc) {
            __builtin_amdgcn_fence(__ATOMIC_RELEASE, "agent");
            asm volatile("s_waitcnt vmcnt(0)" ::: "memory");
            const unsigned og = xb_add(&bar[XB_TOP], 1u);
            const unsigned tg = og / nx;
            if (og + 1u == (tg + 1u) * nx) xb_add(&bar[XB_TOPGEN], 1u);
            else XB_SPIN(xb_ld(&bar[XB_TOPGEN]) == tg, bar);
            __builtin_amdgcn_fence(__ATOMIC_ACQUIRE, "agent");
            xb_add(&bar[XB_XGEN(b.x)], 1u);
            asm volatile("s_waitcnt vmcnt(0)" ::: "memory");
        } else {
            XB_SPIN(xb_ld(&bar[XB_XGEN(b.x)]) == gen, bar);
            __builtin_amdgcn_fence(__ATOMIC_ACQUIRE, "agent");
            asm volatile("s_waitcnt vmcnt(0)" ::: "memory");
        }
    }
    __syncthreads();
}
#ifndef MK_ONE_LAUNCH
#define MK_ONE_LAUNCH 1
#endif
typedef float f32x2 __attribute__((ext_vector_type(2)));
__device__ __forceinline__ float wave_sum(float v) {
#pragma unroll
    for (int o = 1; o < 64; o <<= 1) v += __shfl_xor(v, o);
    return v;
}
__device__ __forceinline__ float bf2f(unsigned short h) { return __builtin_bit_cast(float, (unsigned)h << 16); }
__device__ __forceinline__ float bflo(unsigned w) { return __builtin_bit_cast(float, w << 16); }
__device__ __forceinline__ float bfhi(unsigned w) { return __builtin_bit_cast(float, w & 0xffff0000u); }
__device__ __forceinline__ float silu(float g) { return g * __builtin_amdgcn_rcpf(1.0f + __expf(-g)); }

template <class RowMap>
__device__ __forceinline__ void transpose_item(const float* W, int K, int N, int NP, bf16* WT, const RowMap& rm, LAS float* scr, int item, int lane) {
    const int nblk = NP / 32, kb = item / nblk, nb = item % nblk, k0 = 64 * kb, n0 = 32 * nb;
    const int r8 = lane >> 3, c4 = lane & 7; const bool ok = n0 + 4 * c4 < N;
    f32x4 v[8];
#pragma unroll
    for (int i = 0; i < 8; ++i) v[i] = ok ? *(const GAS f32x4*)(W + (size_t)(k0 + r8 + 8 * i) * N + n0 + 4 * c4) : (f32x4){0.f, 0.f, 0.f, 0.f};
#pragma unroll
    for (int i = 0; i < 8; ++i) { LAS float* d = scr + (r8 + 8 * i) * 33 + 4 * c4; d[0] = v[i].x; d[1] = v[i].y; d[2] = v[i].z; d[3] = v[i].w; }
    LDS_WAIT(); asm volatile("" ::: "memory");
    const int c = lane & 7;
#pragma unroll
    for (int j = 0; j < 4; ++j) { const int n = (lane >> 3) + 8 * j; const LAS float* s = scr + (8 * c) * 33 + n;
        v4u o; o.x = pk2(s[0 * 33], s[1 * 33]); o.y = pk2(s[2 * 33], s[3 * 33]); o.z = pk2(s[4 * 33], s[5 * 33]); o.w = pk2(s[6 * 33], s[7 * 33]);
        *(GAS v4u*)(WT + (size_t)rm(n0 + n) * K + k0 + 8 * c) = o; }
    LDS_WAIT(); asm volatile("" ::: "memory");
}
struct RmId { __device__ __forceinline__ int operator()(int n) const { return n; } };
struct RmFfnIn { __device__ __forceinline__ int operator()(int n) const { const int up = n >= DFF, j = n - up * DFF; return (j >> 7) * 256 + up * 128 + (j & 127); } };
struct RmMixIn { __device__ __forceinline__ int operator()(int n) const { if (n >= 2048) return n; const int p = n & 63; if (p >= 4 && p < 12) return (n & ~63) + (p ^ 12); return n; } };

__device__ __forceinline__ void ln_row(const float* yrow, float* xrow, bf16* brow, const float* g, const float* b, int lane) {
    const GAS f32x4* yr = (const GAS f32x4*)yrow + lane;
    f32x4 v[8]; float s = 0.f;
#pragma unroll
    for (int j = 0; j < 8; ++j) { v[j] = yr[64 * j]; s += (v[j].x + v[j].y) + (v[j].z + v[j].w); }
    const float mean = wave_sum(s) * (1.f / D); float s2 = 0.f;
#pragma unroll
    for (int j = 0; j < 8; ++j) { v[j] = v[j] - mean; s2 += (v[j].x * v[j].x + v[j].y * v[j].y) + (v[j].z * v[j].z + v[j].w * v[j].w); }
    const float rstd = 1.f / sqrtf(wave_sum(s2) * (1.f / D) + LN_EPS);
    GAS f32x4* xo = (GAS f32x4*)xrow + lane; GAS unsigned long long* o8 = (GAS unsigned long long*)brow + lane;
    const GAS f32x4* gp = (const GAS f32x4*)g + lane; const GAS f32x4* bp = (const GAS f32x4*)b + lane;
#pragma unroll
    for (int j = 0; j < 8; ++j) { const f32x4 o = v[j] * rstd * gp[64 * j] + bp[64 * j]; xo[64 * j] = o;
        o8[64 * j] = (unsigned long long)pk2(o.x, o.y) | ((unsigned long long)pk2(o.z, o.w) << 32); }
}

template <class RowMap>
__device__ __forceinline__ void fold_task(const float* W, int K, int N, int NP, bf16* WT, const RowMap& rm, const float* g, const float* b, bool hasln, float* cs, float* bw, LAS float* scr, LAS float* part, int nb, int wave, int lane) {
    const int n0 = 32 * nb, kbn = K / 512, kb0 = wave * kbn;
    const int r8 = lane >> 3, c4 = lane & 7; const bool ok = n0 + 4 * c4 < N; const int c = lane & 7;
    float pcs[4] = {0.f, 0.f, 0.f, 0.f}, pbw[4] = {0.f, 0.f, 0.f, 0.f};
    f32x4 cur[8];
#pragma unroll
    for (int i = 0; i < 8; ++i) cur[i] = ok ? *(const GAS f32x4*)(W + (size_t)(64 * kb0 + r8 + 8 * i) * N + n0 + 4 * c4) : (f32x4){0.f, 0.f, 0.f, 0.f};
#pragma unroll 1
    for (int kb = kb0; kb < kb0 + kbn; ++kb) { const int k0 = 64 * kb;
#pragma unroll
        for (int i = 0; i < 8; ++i) { LAS float* d = scr + (r8 + 8 * i) * 33 + 4 * c4; d[0] = cur[i].x; d[1] = cur[i].y; d[2] = cur[i].z; d[3] = cur[i].w; }
        if (kb + 1 < kb0 + kbn) {
#pragma unroll
            for (int i = 0; i < 8; ++i) cur[i] = ok ? *(const GAS f32x4*)(W + (size_t)(k0 + 64 + r8 + 8 * i) * N + n0 + 4 * c4) : (f32x4){0.f, 0.f, 0.f, 0.f}; }
        f32x4 g0 = *(const GAS f32x4*)(g + k0 + 8 * c), g1 = *(const GAS f32x4*)(g + k0 + 8 * c + 4), b0 = *(const GAS f32x4*)(b + k0 + 8 * c), b1 = *(const GAS f32x4*)(b + k0 + 8 * c + 4);
        if (!hasln) { g0 = (f32x4){1.f, 1.f, 1.f, 1.f}; g1 = g0; b0 = (f32x4){0.f, 0.f, 0.f, 0.f}; b1 = b0; }
        LDS_WAIT(); asm volatile("" ::: "memory");
#pragma unroll
        for (int j = 0; j < 4; ++j) { const int n = (lane >> 3) + 8 * j; const LAS float* s = scr + (8 * c) * 33 + n;
            const float s0 = s[0], s1 = s[33], s2 = s[66], s3 = s[99], s4 = s[132], s5 = s[165], s6 = s[198], s7 = s[231];
            v4u o; o.x = pk2(s0 * g0.x, s1 * g0.y); o.y = pk2(s2 * g0.z, s3 * g0.w); o.z = pk2(s4 * g1.x, s5 * g1.y); o.w = pk2(s6 * g1.z, s7 * g1.w);
            *(GAS v4u*)(WT + (size_t)rm(n0 + n) * K + k0 + 8 * c) = o;
            pcs[j] += ((bflo(o.x) + bfhi(o.x)) + (bflo(o.y) + bfhi(o.y))) + ((bflo(o.z) + bfhi(o.z)) + (bflo(o.w) + bfhi(o.w)));
            pbw[j] += ((s0 * b0.x + s1 * b0.y) + (s2 * b0.z + s3 * b0.w)) + ((s4 * b1.x + s5 * b1.y) + (s6 * b1.z + s7 * b1.w)); }
        LDS_WAIT(); asm volatile("" ::: "memory");
    }
#pragma unroll
    for (int j = 0; j < 4; ++j) { float a = pcs[j], d = pbw[j];
        a += __shfl_xor(a, 1); d += __shfl_xor(d, 1); a += __shfl_xor(a, 2); d += __shfl_xor(d, 2); a += __shfl_xor(a, 4); d += __shfl_xor(d, 4);
        if (c == 0) { const int n = (lane >> 3) + 8 * j; part[(wave * 32 + n) * 2] = a; part[(wave * 32 + n) * 2 + 1] = d; } }
    __syncthreads();
    if (wave == 0 && lane < 32) { float a = 0.f, d = 0.f;
#pragma unroll
        for (int w = 0; w < 8; ++w) { a += part[(w * 32 + lane) * 2]; d += part[(w * 32 + lane) * 2 + 1]; }
        const int r = rm(n0 + lane); cs[r] = a; bw[r] = d; }
    __syncthreads();
}
__device__ __forceinline__ void finalize_stats(const float* PS, float* stats, int gt, int ngt) {
    const int q = gt & 15;
    for (int r = gt >> 4; r < M; r += ngt >> 4) { const f32x4 v = *((const GAS f32x4*)(PS + (size_t)r * 64) + q); float s1 = v.x + v.z, s2 = v.y + v.w;
        s1 += __shfl_xor(s1, 1); s2 += __shfl_xor(s2, 1); s1 += __shfl_xor(s1, 2); s2 += __shfl_xor(s2, 2); s1 += __shfl_xor(s1, 4); s2 += __shfl_xor(s2, 4); s1 += __shfl_xor(s1, 8); s2 += __shfl_xor(s2, 8);
        const float mu = s1 * (1.f / D), var = fmaxf(s2 * (1.f / D) - mu * mu, 0.f);
        if (q == 0) *(GAS f32x2*)(stats + 2 * (size_t)r) = (f32x2){mu, 1.0f / sqrtf(var + LN_EPS)}; }
}
__device__ __forceinline__ void final_ln_row(float* orow, const bf16* hrow, const unsigned char* lrow, const float* psrow, const float* g, const float* b, int lane) {
    const f32x2 pv = *(const GAS f32x2*)(psrow + 2 * (lane & 31)); float s1 = pv.x, s2 = pv.y;
#pragma unroll
    for (int o = 1; o < 32; o <<= 1) { s1 += __shfl_xor(s1, o); s2 += __shfl_xor(s2, o); }
    const float mu = s1 * (1.f / D), rstd = 1.0f / sqrtf(fmaxf(s2 * (1.f / D) - mu * mu, 0.f) + LN_EPS);
    typedef unsigned u32x2_ __attribute__((ext_vector_type(2)));
    GAS f32x4* yr = (GAS f32x4*)orow + lane; const GAS f32x4* gp = (const GAS f32x4*)g + lane; const GAS f32x4* bp = (const GAS f32x4*)b + lane;
    const GAS u32x2_* hp = (const GAS u32x2_*)hrow + lane; const GAS unsigned* lp = (const GAS unsigned*)lrow + lane;
    u32x2_ vh[8]; unsigned vl[8];
#pragma unroll
    for (int j = 0; j < 8; ++j) { vh[j] = hp[64 * j]; vl[j] = lp[64 * j]; }
#pragma unroll
    for (int j = 0; j < 8; ++j) { const f32x2 p0 = __builtin_amdgcn_cvt_pk_f32_bf8((int)vl[j], false), p1 = __builtin_amdgcn_cvt_pk_f32_bf8((int)vl[j], true);
        const f32x4 v = (f32x4){bflo(vh[j].x) + p0.x * YLO_IS, bfhi(vh[j].x) + p0.y * YLO_IS, bflo(vh[j].y) + p1.x * YLO_IS, bfhi(vh[j].y) + p1.y * YLO_IS};
        yr[64 * j] = (v - mu) * rstd * gp[64 * j] + bp[64 * j]; }
}
namespace gdn {
typedef float f32x16 __attribute__((ext_vector_type(16)));
typedef float f32x2_t __attribute__((ext_vector_type(2))); typedef __bf16 bf16x2_t __attribute__((ext_vector_type(2)));
typedef unsigned u32x2 __attribute__((ext_vector_type(2)));
__device__ __forceinline__ unsigned cvtpk(float lo, float hi) { f32x2_t v = {lo, hi}; bf16x2_t b = __builtin_convertvector(v, bf16x2_t); return __builtin_bit_cast(unsigned, b); }
__device__ __forceinline__ int crow(int r, int hi) { return (r & 3) + 8 * (r >> 2) + 4 * hi; }
template <int S_> __device__ __forceinline__ bf16x8 packB(const f32x16& x) { v4u p; p.x = cvtpk(x[8 * S_], x[8 * S_ + 1]); p.y = cvtpk(x[8 * S_ + 2], x[8 * S_ + 3]); p.z = cvtpk(x[8 * S_ + 4], x[8 * S_ + 5]); p.w = cvtpk(x[8 * S_ + 6], x[8 * S_ + 7]); return __builtin_bit_cast(bf16x8, p); }
#define GDN_MFMA(a, b, c) __builtin_amdgcn_mfma_f32_32x32x16_bf16((a), (b), (c), 0, 0, 0)
constexpr int OFF_W = 0, OFF_QD = 16384, OFF_KDT = 32768, OFF_AT = 49152, OFF_U = 57344, CHB = 73728, ABYTES = 55296;
constexpr int G2_OT = 2 * ABYTES, OTP = 272;
constexpr int TP = 272, ATP = 144;
constexpr int L_QT = 0, L_KT = 17408, L_VT = 34816, L_WT = 52224, L_LT = 69632, L_AT = 86016, L_GC = 95232, L_BETA = L_GC + 256, L_BE = L_BETA + 256, L_EG = L_BE + 256, L_EGL = L_EG + 256, L_END = L_EGL + 256;

__device__ __forceinline__ void exp_frag(const LAS unsigned char* tile, int pitch, int rowbase, int kb, const LAS float* rowscale, GAS v4u* dst, int lane) {
    const int r32 = lane & 31, hi = lane >> 5, row = rowbase + r32;
    const LAS unsigned char* p = tile + row * pitch + (kb + 4 * hi) * 2;
    u32x2 a = *(const LAS u32x2*)p, b = *(const LAS u32x2*)(p + 16);
    if (rowscale) { const float sc = rowscale[row];
        a.x = cvtpk(bflo(a.x) * sc, bfhi(a.x) * sc); a.y = cvtpk(bflo(a.y) * sc, bfhi(a.y) * sc); b.x = cvtpk(bflo(b.x) * sc, bfhi(b.x) * sc); b.y = cvtpk(bflo(b.y) * sc, bfhi(b.y) * sc); }
    v4u o; o.x = a.x; o.y = a.y; o.z = b.x; o.w = b.y; dst[lane] = o;
}

__device__ __forceinline__ void g1_chunk(LAS unsigned char* L, int tid, int ci, const bf16* P, const float* BA, const float* cw, float aexp, float dtb, unsigned char* blk, float* CD) {
    const int lane = tid & 63, wave = __builtin_amdgcn_readfirstlane(tid >> 6), r32 = lane & 31, hi = lane >> 5;
    const int n = ci & 31, h = (ci >> 5) & 7, b = ci >> 8, r0 = b * SEQ + 64 * n;
    LAS float* GC = (LAS float*)(L + L_GC); LAS float* BETA = (LAS float*)(L + L_BETA); LAS float* BE = (LAS float*)(L + L_BE); LAS float* EG = (LAS float*)(L + L_EG); LAS float* EGL = (LAS float*)(L + L_EGL);
    float db_pre = 0.f, da_pre = 0.f; if (wave == 0) { const size_t r = (size_t)(r0 + lane); db_pre = BA[r * 16 + h]; da_pre = BA[r * 16 + 8 + h]; }
    {   const int rowq = 4 * wave + (lane >> 4), c16 = lane & 15;
#pragma unroll 1
        for (int half = 0; half < 2; ++half) {
        v4u raw[3][4]; const int row = 32 * half + rowq, s = 64 * n + row;
#pragma unroll
        for (int sec = 0; sec < 3; ++sec) { const int chl = sec * 1024 + h * 128 + 8 * c16;
#pragma unroll
            for (int j = 0; j < 4; ++j) raw[sec][j] = (s - 3 + j >= 0) ? *(const GAS v4u*)(P + (size_t)(r0 + row - 3 + j) * PW + 3072 + chl) : (v4u){0u, 0u, 0u, 0u}; }
        __builtin_amdgcn_sched_barrier(0);
#pragma unroll
        for (int sec = 0; sec < 3; ++sec) {
            float a[8];
#pragma unroll
            for (int e = 0; e < 8; ++e) a[e] = 0.f;
#pragma unroll
            for (int j = 0; j < 4; ++j) { const v4u w = raw[sec][j]; const int chl = sec * 1024 + h * 128 + 8 * c16; const f32x4 c0 = *(const GAS f32x4*)(cw + j * 3072 + chl), c1 = *(const GAS f32x4*)(cw + j * 3072 + chl + 4);
                a[0] += c0.x * bflo(w.x); a[1] += c0.y * bfhi(w.x); a[2] += c0.z * bflo(w.y); a[3] += c0.w * bfhi(w.y);
                a[4] += c1.x * bflo(w.z); a[5] += c1.y * bfhi(w.z); a[6] += c1.z * bflo(w.w); a[7] += c1.w * bfhi(w.w); }
            float ss = 0.f;
#pragma unroll
            for (int e = 0; e < 8; ++e) { a[e] = silu(a[e]); ss += a[e] * a[e]; }
            if (sec < 2) { ss += __shfl_xor(ss, 1); ss += __shfl_xor(ss, 2); ss += __shfl_xor(ss, 4); ss += __shfl_xor(ss, 8);
                float rn = 1.0f / sqrtf(ss + L2_EPS); if (sec == 0) rn *= 0.08838834764831845f;
#pragma unroll
                for (int e = 0; e < 8; ++e) a[e] *= rn; }
            v4u o; o.x = cvtpk(a[0], a[1]); o.y = cvtpk(a[2], a[3]); o.z = cvtpk(a[4], a[5]); o.w = cvtpk(a[6], a[7]);
            *(LAS v4u*)(L + sec * 17408 + row * TP + c16 * 16) = o; }
        }
    }
    if (wave == 0) { const float db = db_pre, da = da_pre + dtb;
        const float ee = __expf(da); const float sp = da > 15.f ? da : (ee < 1e-3f ? ee * (1.0f - 0.5f * ee) : __logf(1.0f + ee));   float x = -aexp * sp;
#pragma unroll
        for (int off = 1; off < 64; off <<= 1) { const float t = __shfl_up(x, off); if (lane >= off) x += t; }
        const float gl = __shfl(x, 63), bt = 1.0f / (1.0f + __expf(-db)), eg = __expf(x);
        GC[lane] = x; BETA[lane] = bt; BE[lane] = bt * eg; EG[lane] = eg; EGL[lane] = __expf(gl - x);
        if (lane == 63) CD[ci] = eg; }
    LDS_WAIT(); __builtin_amdgcn_s_barrier(); asm volatile("" ::: "memory");
    if (wave < 6) { const int type = wave / 3, t = wave - 3 * type, ti = t >= 1, tj = t == 2;
        const LAS unsigned char* Ab = L + (type ? L_QT : L_KT) + (32 * ti + r32) * TP + hi * 16; const LAS unsigned char* Bb = L + L_KT + (32 * tj + r32) * TP + hi * 16;
        f32x16 acc;
#pragma unroll
        for (int r = 0; r < 16; ++r) acc[r] = 0.f;
#pragma unroll
        for (int ks = 0; ks < 8; ++ks) acc = GDN_MFMA(*(const LAS bf16x8*)(Ab + ks * 32), *(const LAS bf16x8*)(Bb + ks * 32), acc);
        const int j = 32 * tj + r32; const float gj = GC[j];
#pragma unroll
        for (int r = 0; r < 16; ++r) { const int i = 32 * ti + crow(r, hi); const float d = __expf(GC[i] - gj);
            if (type == 0) ((LAS float*)(L + L_LT))[i * 64 + j] = (i > j) ? acc[r] * BETA[i] * d : 0.f;
            else *(LAS unsigned short*)(L + L_AT + i * ATP + j * 2) = (unsigned short)f2bf((i >= j) ? acc[r] * d : 0.f); }
    }
    LDS_WAIT(); __builtin_amdgcn_s_barrier(); asm volatile("" ::: "memory");
    constexpr int L_XT = L_WT, L_DT = L_QT;
    if (wave < 4) {
        const int col = tid & 127, colg = tid & 255; const bool isW = wave >= 2;
        unsigned ltb = L_LT, rsb = isW ? L_BE : L_BETA; asm volatile("" : "+v"(ltb), "+v"(rsb));
        const LAS unsigned char* src = L + (isW ? L_KT : L_VT) + col * 2; const LAS float* rs = (const LAS float*)(L + rsb); const LAS f32x4* LT4 = (const LAS f32x4*)(L + ltb);
        float x[64];
#pragma unroll
        for (int i = 0; i < 32; ++i) x[i] = bf2f(*(const LAS unsigned short*)(src + i * TP)) * rs[i];
        f32x4 lr[2][8];
#define G1_NFMA(acc_, l_, x_) asm("v_fma_f32 %0, -%1, %2, %0" : "+v"(acc_) : "v"(l_), "v"(x_))
#define G1_SUBST(R0) do { lr[1][0] = LT4[((R0) + 1) * 16 + (R0) / 4]; \
        _Pragma("unroll") for (int i = 1; i < 32; ++i) { \
            if (i + 1 < 32) { _Pragma("unroll") for (int jj = 0; jj < (i + 4) / 4; ++jj) lr[(i + 1) & 1][jj] = LT4[((R0) + i + 1) * 16 + (R0) / 4 + jj]; } \
            __builtin_amdgcn_sched_barrier(0); \
            float a0 = x[(R0) + i], a1 = 0.f, a2 = 0.f, a3 = 0.f; \
            _Pragma("unroll") for (int jj = 0; jj < (i + 3) / 4; ++jj) { const f32x4 l4 = lr[i & 1][jj]; \
                G1_NFMA(a0, l4.x, x[(R0) + 4 * jj]); if (4 * jj + 1 < i) G1_NFMA(a1, l4.y, x[(R0) + 4 * jj + 1]); if (4 * jj + 2 < i) G1_NFMA(a2, l4.z, x[(R0) + 4 * jj + 2]); if (4 * jj + 3 < i) G1_NFMA(a3, l4.w, x[(R0) + 4 * jj + 3]); } \
            x[(R0) + i] = (a0 + a1) + (a2 + a3); \
            __builtin_amdgcn_sched_barrier(0); } } while (0)
        G1_SUBST(0);
#pragma unroll
        for (int q = 0; q < 4; ++q) { v4u o; o.x = cvtpk(x[8 * q], x[8 * q + 1]); o.y = cvtpk(x[8 * q + 2], x[8 * q + 3]); o.z = cvtpk(x[8 * q + 4], x[8 * q + 5]); o.w = cvtpk(x[8 * q + 6], x[8 * q + 7]);
            *(LAS v4u*)(L + L_XT + colg * 64 + q * 16) = o; }
        LDS_WAIT(); __builtin_amdgcn_s_barrier(); asm volatile("" ::: "memory");
        __builtin_amdgcn_s_barrier(); asm volatile("" ::: "memory");
#pragma unroll
        for (int q = 0; q < 4; ++q) { const v4u d = *(const LAS v4u*)(L + L_DT + colg * 64 + q * 16);
#define G1_RB(e_, val_) x[32 + 8 * q + (e_)] = bf2f(*(const LAS unsigned short*)(src + (32 + 8 * q + (e_)) * TP)) * rs[32 + 8 * q + (e_)] - (val_)
            G1_RB(0, bflo(d.x)); G1_RB(1, bfhi(d.x)); G1_RB(2, bflo(d.y)); G1_RB(3, bfhi(d.y)); G1_RB(4, bflo(d.z)); G1_RB(5, bfhi(d.z)); G1_RB(6, bflo(d.w)); G1_RB(7, bfhi(d.w));
#undef G1_RB
        }
        G1_SUBST(32);
#undef G1_SUBST
#undef G1_NFMA
        if (!isW) { const int dvt = col >> 5, c32 = col & 31;
#pragma unroll
            for (int ct = 0; ct < 2; ++ct)
#pragma unroll
                for (int hh = 0; hh < 2; ++hh) { GAS v4u* d = (GAS v4u*)(blk + OFF_U + (ct * 4 + dvt) * 2048 + (hh * 32 + c32) * 32);
                    v4u o0, o1;
                    o0.x = cvtpk(x[32 * ct + crow(0, hh)], x[32 * ct + crow(1, hh)]); o0.y = cvtpk(x[32 * ct + crow(2, hh)], x[32 * ct + crow(3, hh)]); o0.z = cvtpk(x[32 * ct + crow(4, hh)], x[32 * ct + crow(5, hh)]); o0.w = cvtpk(x[32 * ct + crow(6, hh)], x[32 * ct + crow(7, hh)]);
                    o1.x = cvtpk(x[32 * ct + crow(8, hh)], x[32 * ct + crow(9, hh)]); o1.y = cvtpk(x[32 * ct + crow(10, hh)], x[32 * ct + crow(11, hh)]); o1.z = cvtpk(x[32 * ct + crow(12, hh)], x[32 * ct + crow(13, hh)]); o1.w = cvtpk(x[32 * ct + crow(14, hh)], x[32 * ct + crow(15, hh)]);
                    d[0] = o0; d[1] = o1; }
        } else {
#pragma unroll
            for (int i = 0; i < 64; ++i) *(LAS unsigned short*)(L + L_WT + i * TP + col * 2) = (unsigned short)f2bf(-x[i]);
        }
    } else { const int w4 = wave - 4;
#pragma unroll 1
        for (int q = 0; q < 4; ++q) { const int f = w4 * 4 + q, rb = f >> 3, kt = (f >> 1) & 3, s = f & 1;
            exp_frag(L + L_QT, TP, 32 * rb, 32 * kt + 16 * s, EG, (GAS v4u*)(blk + OFF_QD + f * 1024), lane); }
        LDS_WAIT(); __builtin_amdgcn_s_barrier(); asm volatile("" ::: "memory");
        {
            const LAS f32x4* LT4 = (const LAS f32x4*)(L + L_LT);
            bf16x8 af[2];
#pragma unroll
            for (int s = 0; s < 2; ++s) { const f32x4 la = LT4[(32 + r32) * 16 + 4 * s + 2 * hi], lb = LT4[(32 + r32) * 16 + 4 * s + 2 * hi + 1];
                v4u ap; ap.x = cvtpk(la.x, la.y); ap.y = cvtpk(la.z, la.w); ap.z = cvtpk(lb.x, lb.y); ap.w = cvtpk(lb.z, lb.w); af[s] = __builtin_bit_cast(bf16x8, ap); }
#pragma unroll
            for (int tt = 0; tt < 2; ++tt) { const int cg = 64 * w4 + 32 * tt + r32;
                f32x16 c;
#pragma unroll
                for (int r = 0; r < 16; ++r) c[r] = 0.f;
#pragma unroll
                for (int s = 0; s < 2; ++s) c = GDN_MFMA(af[s], *(const LAS bf16x8*)(L + L_XT + cg * 64 + (16 * s + 8 * hi) * 2), c);
#pragma unroll
                for (int gq = 0; gq < 4; ++gq) { u32x2 o; o.x = cvtpk(c[4 * gq], c[4 * gq + 1]); o.y = cvtpk(c[4 * gq + 2], c[4 * gq + 3]);
                    *(LAS u32x2*)(L + L_DT + cg * 64 + (8 * gq + 4 * hi) * 2) = o; } }
        }
        LDS_WAIT(); __builtin_amdgcn_s_barrier(); asm volatile("" ::: "memory");
#pragma unroll 1
        for (int q = 0; q < 4; ++q) { const int f = w4 * 4 + q, rb = f >> 2, ct = (f >> 1) & 1, s = f & 1;
            const int dk = 32 * rb + r32; float v[8];
#pragma unroll
            for (int j = 0; j < 8; ++j) { const int c = 32 * ct + 16 * s + 8 * (j >> 2) + 4 * hi + (j & 3); v[j] = bf2f(*(const LAS unsigned short*)(L + L_KT + c * TP + dk * 2)) * EGL[c]; }
            v4u o; o.x = cvtpk(v[0], v[1]); o.y = cvtpk(v[2], v[3]); o.z = cvtpk(v[4], v[5]); o.w = cvtpk(v[6], v[7]);
            ((GAS v4u*)(blk + OFF_KDT + f * 1024))[lane] = o; }
        if (w4 < 3)
#pragma unroll 1
        for (int q = 0; q < 2; ++q) { const int f = w4 * 2 + q, rb = w4 >= 1, ct = w4 == 2, s = q;
            exp_frag(L + L_AT, ATP, 32 * rb, 32 * ct + 16 * s, nullptr, (GAS v4u*)(blk + OFF_AT + f * 1024), lane); }
    }
    LDS_WAIT(); __builtin_amdgcn_s_barrier(); asm volatile("" ::: "memory");
#pragma unroll 1
    for (int q = 0; q < 2; ++q) { const int f = wave * 2 + q, rb = f >> 3, kt = (f >> 1) & 3, s = f & 1;
        exp_frag(L + L_WT, TP, 32 * rb, 32 * kt + 16 * s, nullptr, (GAS v4u*)(blk + OFF_W + f * 1024), lane); }
}

__device__ __forceinline__ void g2_pair(LAS unsigned char* L, int tid, int pair, const unsigned char* gws, const float* CD, const bf16* P, const float* dng, bf16* MIX) {
    const int lane = tid & 63, wave = __builtin_amdgcn_readfirstlane(tid >> 6), r32 = lane & 31, hi = lane >> 5;
    const int b = pair >> 3, h = pair & 7;
    const unsigned char* base = gws + (size_t)pair * 32 * CHB;
    if (wave >= 4) {
        const int lw = wave - 4, t = tid - 256, erow = t >> 2, eq = t & 3;
        float gg[32];
#pragma unroll
        for (int i = 0; i < 8; ++i) { const f32x4 v = *(const GAS f32x4*)(dng + 32 * eq + 4 * i); gg[4 * i] = v.x; gg[4 * i + 1] = v.y; gg[4 * i + 2] = v.z; gg[4 * i + 3] = v.w; }
        {   const unsigned char* src = base + lane * 16; LAS unsigned char* dst = L;
#pragma unroll
            for (int p = 0; p < 14; ++p) if (lw + 4 * p < 54) __builtin_amdgcn_global_load_lds((const GAS unsigned*)(src + (lw + 4 * p) * 1024), (LAS unsigned*)(dst + (lw + 4 * p) * 1024), 16, 0, 0);
            asm volatile("s_waitcnt vmcnt(0)" ::: "memory"); __builtin_amdgcn_s_barrier(); asm volatile("" ::: "memory"); }
        v4u zc[4], zn[4];
#pragma unroll
        for (int i = 0; i < 4; ++i) { zc[i] = (v4u){0u, 0u, 0u, 0u}; zn[i] = zc[i]; }
#pragma unroll 1
        for (int n = 0; n <= 32; ++n) {
            if (n < 32) { const GAS v4u* zp = (const GAS v4u*)(P + (size_t)(b * SEQ + 64 * n + erow) * PW + 6144 + h * 128 + 32 * eq);
                asm volatile("global_load_dwordx4 %0, %4, off\n\tglobal_load_dwordx4 %1, %4, off offset:16\n\tglobal_load_dwordx4 %2, %4, off offset:32\n\tglobal_load_dwordx4 %3, %4, off offset:48"
                             : "=&v"(zn[0]), "=&v"(zn[1]), "=&v"(zn[2]), "=&v"(zn[3]) : "v"(zp) : "memory"); }
            if (n + 1 < 32) { const unsigned char* src = base + (size_t)(n + 1) * CHB + lane * 16; LAS unsigned char* dst = L + ((n + 1) & 1) * ABYTES;
#pragma unroll
                for (int p = 0; p < 14; ++p) if (lw + 4 * p < 54) __builtin_amdgcn_global_load_lds((const GAS unsigned*)(src + (lw + 4 * p) * 1024), (LAS unsigned*)(dst + (lw + 4 * p) * 1024), 16, 0, 0); }
            if (n >= 1) { const size_t row = (size_t)(b * SEQ + 64 * (n - 1) + erow);
                v4u o[4];
#pragma unroll
                for (int i = 0; i < 4; ++i) o[i] = *(const LAS v4u*)(L + G2_OT + erow * OTP + eq * 64 + i * 16);
                float ov[32]; float ss = 0.f;
#pragma unroll
                for (int i = 0; i < 4; ++i) { ov[8 * i] = bflo(o[i].x); ov[8 * i + 1] = bfhi(o[i].x); ov[8 * i + 2] = bflo(o[i].y); ov[8 * i + 3] = bfhi(o[i].y); ov[8 * i + 4] = bflo(o[i].z); ov[8 * i + 5] = bfhi(o[i].z); ov[8 * i + 6] = bflo(o[i].w); ov[8 * i + 7] = bfhi(o[i].w); }
#pragma unroll
                for (int i = 0; i < 32; ++i) ss += ov[i] * ov[i];
                ss += __shfl_xor(ss, 1); ss += __shfl_xor(ss, 2);
                const float rn = 1.0f / sqrtf(ss * (1.f / 128.f) + GN_EPS);
                GAS v4u* mp = (GAS v4u*)(MIX + row * D + 1024 + h * 128 + 32 * eq);
#pragma unroll
                for (int i = 0; i < 4; ++i) { const v4u zz = zc[i]; v4u w;
                    w.x = cvtpk(ov[8 * i] * rn * gg[8 * i] * silu(bflo(zz.x)), ov[8 * i + 1] * rn * gg[8 * i + 1] * silu(bfhi(zz.x)));
                    w.y = cvtpk(ov[8 * i + 2] * rn * gg[8 * i + 2] * silu(bflo(zz.y)), ov[8 * i + 3] * rn * gg[8 * i + 3] * silu(bfhi(zz.y)));
                    w.z = cvtpk(ov[8 * i + 4] * rn * gg[8 * i + 4] * silu(bflo(zz.z)), ov[8 * i + 5] * rn * gg[8 * i + 5] * silu(bfhi(zz.z)));
                    w.w = cvtpk(ov[8 * i + 6] * rn * gg[8 * i + 6] * silu(bflo(zz.w)), ov[8 * i + 7] * rn * gg[8 * i + 7] * silu(bfhi(zz.w)));
                    mp[i] = w; }
            }
            if (n < 32) { LDS_WAIT(); __builtin_amdgcn_s_barrier(); asm volatile("" ::: "memory");
                if (n >= 1) asm volatile("s_waitcnt vmcnt(4)" ::: "memory"); else asm volatile("s_waitcnt vmcnt(0)" ::: "memory");
                asm volatile("" : "+v"(zn[0]), "+v"(zn[1]), "+v"(zn[2]), "+v"(zn[3]));
#pragma unroll
                for (int i = 0; i < 4; ++i) zc[i] = zn[i];
                __builtin_amdgcn_s_barrier(); asm volatile("" ::: "memory"); }
        }
    } else {
        f32x16 S[4];
#pragma unroll
        for (int kt = 0; kt < 4; ++kt)
#pragma unroll
            for (int r = 0; r < 16; ++r) S[kt][r] = 0.f;
        v4u un[2][2]; float cdn;
        { const GAS v4u* up = (const GAS v4u*)(base + OFF_U + wave * 2048 + lane * 32); un[0][0] = up[0]; un[0][1] = up[1]; up = (const GAS v4u*)(base + OFF_U + (4 + wave) * 2048 + lane * 32); un[1][0] = up[0]; un[1][1] = up[1]; cdn = CD[pair * 32]; }
        __builtin_amdgcn_s_barrier(); asm volatile("" ::: "memory");
#pragma unroll 1
        for (int n = 0; n < 32; ++n) {
            const LAS unsigned char* buf = L + (n & 1) * ABYTES + lane * 16;
            f32x16 vn[2], o[2]; const float cd = cdn;
#pragma unroll
            for (int ct = 0; ct < 2; ++ct) { const v4u a = un[ct][0], c = un[ct][1];
                vn[ct][0] = bflo(a.x); vn[ct][1] = bfhi(a.x); vn[ct][2] = bflo(a.y); vn[ct][3] = bfhi(a.y); vn[ct][4] = bflo(a.z); vn[ct][5] = bfhi(a.z); vn[ct][6] = bflo(a.w); vn[ct][7] = bfhi(a.w);
                vn[ct][8] = bflo(c.x); vn[ct][9] = bfhi(c.x); vn[ct][10] = bflo(c.y); vn[ct][11] = bfhi(c.y); vn[ct][12] = bflo(c.z); vn[ct][13] = bfhi(c.z); vn[ct][14] = bflo(c.w); vn[ct][15] = bfhi(c.w); }
            if (n + 1 < 32) { const unsigned char* nb = base + (size_t)(n + 1) * CHB; const GAS v4u* up = (const GAS v4u*)(nb + OFF_U + wave * 2048 + lane * 32); un[0][0] = up[0]; un[0][1] = up[1];
                up = (const GAS v4u*)(nb + OFF_U + (4 + wave) * 2048 + lane * 32); un[1][0] = up[0]; un[1][1] = up[1]; cdn = CD[pair * 32 + n + 1]; }
#define GDN_AF(off) (*(const LAS bf16x8*)(buf + (off)))
#define GDN_LD8(dst, base) do { _Pragma("unroll") for (int q_ = 0; q_ < 8; ++q_) dst[q_] = GDN_AF((base) + q_ * 1024); } while (0)
#define GDN_SB() __builtin_amdgcn_sched_barrier(0)
            bf16x8 fa[4], fb[4];
#define GDN_LDK(dst, kt, s) do { _Pragma("unroll") for (int q_ = 0; q_ < 4; ++q_) dst[q_] = GDN_AF(((q_ & 2) ? OFF_QD : OFF_W) + (((q_ & 1) * 4 + (kt)) * 2 + (s)) * 1024); } while (0)
#define GDN_STK(src, pk) do { const bf16x8 p_ = (pk); vn[0] = GDN_MFMA(src[0], p_, vn[0]); vn[1] = GDN_MFMA(src[1], p_, vn[1]); o[0] = GDN_MFMA(src[2], p_, o[0]); o[1] = GDN_MFMA(src[3], p_, o[1]); } while (0)
            GDN_LDK(fa, 0, 0);
#pragma unroll
            for (int r = 0; r < 16; ++r) { o[0][r] = 0.f; o[1][r] = 0.f; }
            GDN_SB(); GDN_LDK(fb, 0, 1); GDN_SB(); GDN_STK(fa, packB<0>(S[0]));
            GDN_SB(); GDN_LDK(fa, 1, 0); GDN_SB(); GDN_STK(fb, packB<1>(S[0]));
            GDN_SB(); GDN_LDK(fb, 1, 1); GDN_SB(); GDN_STK(fa, packB<0>(S[1]));
            GDN_SB(); GDN_LDK(fa, 2, 0); GDN_SB(); GDN_STK(fb, packB<1>(S[1]));
            GDN_SB(); GDN_LDK(fb, 2, 1); GDN_SB(); GDN_STK(fa, packB<0>(S[2]));
            GDN_SB(); GDN_LDK(fa, 3, 0); GDN_SB(); GDN_STK(fb, packB<1>(S[2]));
            GDN_SB(); GDN_LDK(fb, 3, 1); GDN_SB(); GDN_STK(fa, packB<0>(S[3]));
            GDN_SB();
#pragma unroll
            for (int q = 0; q < 4; ++q) fa[q] = GDN_AF(OFF_AT + q * 1024);
            GDN_SB(); GDN_STK(fb, packB<1>(S[3]));
#undef GDN_LDK
#undef GDN_STK
            bf16x8 pv[2][2];
#pragma unroll
            for (int ct = 0; ct < 2; ++ct) { pv[ct][0] = packB<0>(vn[ct]); pv[ct][1] = packB<1>(vn[ct]); }
            GDN_SB(); fb[0] = GDN_AF(OFF_AT + 4 * 1024); fb[1] = GDN_AF(OFF_AT + 5 * 1024); fb[2] = GDN_AF(OFF_KDT); fb[3] = GDN_AF(OFF_KDT + 1024); GDN_SB();
            o[0] = GDN_MFMA(fa[0], pv[0][0], o[0]); o[1] = GDN_MFMA(fa[2], pv[0][0], o[1]); o[0] = GDN_MFMA(fa[1], pv[0][1], o[0]); o[1] = GDN_MFMA(fa[3], pv[0][1], o[1]);
            GDN_SB(); fa[0] = GDN_AF(OFF_KDT + 2048); fa[1] = GDN_AF(OFF_KDT + 3072); fa[2] = GDN_AF(OFF_KDT + 4096); fa[3] = GDN_AF(OFF_KDT + 5120); GDN_SB();
#pragma unroll
            for (int r = 0; r < 16; ++r) { S[0][r] *= cd; S[1][r] *= cd; }
            o[1] = GDN_MFMA(fb[0], pv[1][0], o[1]); S[0] = GDN_MFMA(fb[2], pv[0][0], S[0]); o[1] = GDN_MFMA(fb[1], pv[1][1], o[1]); S[0] = GDN_MFMA(fb[3], pv[0][1], S[0]);
            GDN_SB(); fb[0] = GDN_AF(OFF_KDT + 6144); fb[1] = GDN_AF(OFF_KDT + 7168); fb[2] = GDN_AF(OFF_KDT + 8192); fb[3] = GDN_AF(OFF_KDT + 9216); GDN_SB();
            S[0] = GDN_MFMA(fa[0], pv[1][0], S[0]); S[1] = GDN_MFMA(fa[2], pv[0][0], S[1]); S[0] = GDN_MFMA(fa[1], pv[1][1], S[0]); S[1] = GDN_MFMA(fa[3], pv[0][1], S[1]);
            GDN_SB(); fa[0] = GDN_AF(OFF_KDT + 10240); fa[1] = GDN_AF(OFF_KDT + 11264); fa[2] = GDN_AF(OFF_KDT + 12288); fa[3] = GDN_AF(OFF_KDT + 13312); GDN_SB();
#pragma unroll
            for (int r = 0; r < 16; ++r) { S[2][r] *= cd; S[3][r] *= cd; }
            S[1] = GDN_MFMA(fb[0], pv[1][0], S[1]); S[2] = GDN_MFMA(fb[2], pv[0][0], S[2]); S[1] = GDN_MFMA(fb[1], pv[1][1], S[1]); S[2] = GDN_MFMA(fb[3], pv[0][1], S[2]);
            GDN_SB(); fb[0] = GDN_AF(OFF_KDT + 14336); fb[1] = GDN_AF(OFF_KDT + 15360); GDN_SB();
            S[2] = GDN_MFMA(fa[0], pv[1][0], S[2]); S[3] = GDN_MFMA(fa[2], pv[0][0], S[3]); S[2] = GDN_MFMA(fa[1], pv[1][1], S[2]); S[3] = GDN_MFMA(fa[3], pv[0][1], S[3]);
            GDN_SB();
            S[3] = GDN_MFMA(fb[0], pv[1][0], S[3]); S[3] = GDN_MFMA(fb[1], pv[1][1], S[3]);
#undef GDN_AF
#undef GDN_LD8
#undef GDN_SB
            LDS_WAIT(); __builtin_amdgcn_s_barrier(); asm volatile("" ::: "memory");
#pragma unroll
            for (int ct = 0; ct < 2; ++ct)
#pragma unroll
                for (int r = 0; r < 16; ++r) *(LAS unsigned short*)(L + G2_OT + (32 * ct + crow(r, hi)) * OTP + (32 * wave + r32) * 2) = (unsigned short)f2bf(o[ct][r]);
            LDS_WAIT(); __builtin_amdgcn_s_barrier(); asm volatile("" ::: "memory");
        }
    }
}
__device__ __forceinline__ void diff_combine_blocks(int wave, int lane, const bf16* OB, bf16* MIX, const float* dg, float lam, float oml, int b, int h, unsigned qbmask) {
    const int sub = lane >> 4, c16 = lane & 15, vh = c16 >> 3, dd = (8 * c16) & 63;
    const f32x4 g0 = *(const GAS f32x4*)(dg + 8 * c16) * oml, g1 = *(const GAS f32x4*)(dg + 8 * c16 + 4) * oml;
    for (int qb = 0; qb < 8; ++qb) { if (!((qbmask >> qb) & 1u)) continue;
#pragma unroll 1
        for (int it0 = wave * 4; it0 < 64; it0 += NWAVES * 4) {
            v4u a[4], c[4];
#pragma unroll
            for (int q = 0; q < 4; ++q) { const int r = b * SEQ + 256 * qb + (it0 + q) * 4 + sub;
                a[q] = *(const GAS v4u*)(OB + (size_t)r * D + ((h * 2 + 0) * 2 + vh) * 64 + dd); c[q] = *(const GAS v4u*)(OB + (size_t)r * D + ((h * 2 + 1) * 2 + vh) * 64 + dd); }
#pragma unroll
            for (int q = 0; q < 4; ++q) { const int r = b * SEQ + 256 * qb + (it0 + q) * 4 + sub;
                float o[8]; o[0] = bflo(a[q].x) - lam * bflo(c[q].x); o[1] = bfhi(a[q].x) - lam * bfhi(c[q].x); o[2] = bflo(a[q].y) - lam * bflo(c[q].y); o[3] = bfhi(a[q].y) - lam * bfhi(c[q].y);
                o[4] = bflo(a[q].z) - lam * bflo(c[q].z); o[5] = bfhi(a[q].z) - lam * bfhi(c[q].z); o[6] = bflo(a[q].w) - lam * bflo(c[q].w); o[7] = bfhi(a[q].w) - lam * bfhi(c[q].w);
                float ss = 0.f;
#pragma unroll
                for (int e = 0; e < 8; ++e) ss += o[e] * o[e];
                ss += __shfl_xor(ss, 1); ss += __shfl_xor(ss, 2); ss += __shfl_xor(ss, 4); ss += __shfl_xor(ss, 8);
                const float rn = 1.0f / sqrtf(ss * (1.f / 128.f) + SUBLN_EPS);
                v4u w; w.x = cvtpk(o[0] * rn * g0.x, o[1] * rn * g0.y); w.y = cvtpk(o[2] * rn * g0.z, o[3] * rn * g0.w); w.z = cvtpk(o[4] * rn * g1.x, o[5] * rn * g1.y); w.w = cvtpk(o[6] * rn * g1.z, o[7] * rn * g1.w);
                *(GAS v4u*)(MIX + (size_t)r * D + h * 128 + 8 * c16) = w; } } }
}
}
struct Args { const void* in[23]; float* out; unsigned char* ws; int ph_lo, ph_hi; };
#define PH_BEGIN() asm volatile("" ::: "memory"); int tid = threadIdx.x; asm volatile("" : "+v"(tid)); int bx_ = blockIdx.x; asm volatile("" : "+s"(bx_)); \
    const int lane = tid & 63, wave = __builtin_amdgcn_readfirstlane(tid >> 6), G = gridDim.x, vcu = (G % 8 == 0) ? (bx_ % 8) * (G / 8) + bx_ / 8 : bx_; \
    unsigned char* const ws = ptab(I_WS); (void)lane; (void)wave; (void)vcu; (void)ws
#define GWAVES() const int gw = vcu * NWAVES + wave, NGW = G * NWAVES
#define PIN_F(i) ((const float*)ptab(i))


__device__ __forceinline__ void ba_rows(const bf16* XB, const bf16* WBA, const float* stats, const float* cs, const float* bw, float* BA, int row0, int lane) {
    const int r16 = lane & 15, kq = lane >> 4;
    const GAS v4u* ap = (const GAS v4u*)(XB + (size_t)(row0 + r16) * D + 8 * kq);
    const GAS v4u* bp = (const GAS v4u*)(WBA + (size_t)r16 * D + 8 * kq);
    f32x4 acc0 = (f32x4){0.f, 0.f, 0.f, 0.f}, acc1 = acc0;
    v4u a[2][8], b[2][8];
#define BA_LOAD(u_, bt_) do { _Pragma("unroll") for (int j = 0; j < 8; ++j) { a[u_][j] = ap[((bt_) * 8 + j) * 4]; b[u_][j] = bp[((bt_) * 8 + j) * 4]; } } while (0)
#define BA_MUL(u_) do { _Pragma("unroll") for (int j = 0; j < 8; j += 2) { \
        acc0 = __builtin_amdgcn_mfma_f32_16x16x32_bf16(__builtin_bit_cast(bf16x8, a[u_][j]), __builtin_bit_cast(bf16x8, b[u_][j]), acc0, 0, 0, 0); \
        acc1 = __builtin_amdgcn_mfma_f32_16x16x32_bf16(__builtin_bit_cast(bf16x8, a[u_][j + 1]), __builtin_bit_cast(bf16x8, b[u_][j + 1]), acc1, 0, 0, 0); } } while (0)
    BA_LOAD(0, 0);
#pragma unroll 1
    for (int bt = 0; bt < 8; bt += 2) {
        BA_LOAD(1, bt + 1);
        BA_MUL(0);
        if (bt + 2 < 8) BA_LOAD(0, bt + 2);
        BA_MUL(1);
    }
#undef BA_LOAD
#undef BA_MUL
    const f32x4 acc = acc0 + acc1;
    const float c_ = cs[7168 + r16], w_ = bw[7168 + r16];
#pragma unroll
    for (int i = 0; i < 4; ++i) { const int row = row0 + 4 * kq + i; const f32x2 st = *(const GAS f32x2*)(stats + 2 * (size_t)row);
        BA[(size_t)row * 16 + r16] = (acc[i] - c_ * st.x) * st.y + w_; }
}
__device__ __forceinline__ void convert_ffn(int fj, unsigned char* ws, LAS unsigned char* L, int vcu, int G, int wave, int lane) {
    const int l = fj >> 1, second = fj & 1, lp = l > 0 ? l - 1 : 0; const bool hasln = fj > 0;
    const float* w_in_f = PIN_F(second ? I_F2IN : I_F1IN) + (size_t)l * D * NFI; const float* w_out_f = PIN_F(second ? I_F2OUT : I_F1OUT) + (size_t)l * DFF * D;
    const float* lg = second ? PIN_F(I_LN2G) + (size_t)l * D : PIN_F(I_LN3G) + (size_t)lp * D;
    const float* lb = second ? PIN_F(I_LN2B) + (size_t)l * D : PIN_F(I_LN3B) + (size_t)lp * D;
    bf16* WFI = (bf16*)(ws + WS_WFI); bf16* WFO = (bf16*)(ws + (second ? WS_WFO2 : WS_WFO));
    LAS float* scr = (LAS float*)(L + RING_OFF + wave * 16384); LAS float* part = (LAS float*)(L + RING_OFF + 7 * 16384 + 12288);
    constexpr int I_A = NFI / 32, I_B = (DFF / 64) * (D / 32); const int gw = vcu * NWAVES + wave, NGW = G * NWAVES;
    for (int nb = vcu; nb < I_A; nb += G) fold_task(w_in_f, D, NFI, NFI, WFI, RmFfnIn(), lg, lb, hasln, (float*)(ws + WS_CSF), (float*)(ws + WS_BWF), scr, part, nb, wave, lane);
    for (int it = gw; it < I_B; it += NGW) transpose_item(w_out_f, DFF, D, D, WFO, RmId(), scr, it, lane);
}
__device__ __forceinline__ void convert_mixer(int l, unsigned char* ws, LAS unsigned char* L, int vcu, int G, int wave, int lane) {
    const float* wi = PIN_F(I_WIN) + (size_t)l * D * NIN; const float* wo = PIN_F(I_WOUT) + (size_t)l * D * D;
    const float* lg = PIN_F(I_LN1G) + (size_t)l * D; const float* lb = PIN_F(I_LN1B) + (size_t)l * D;
    bf16* WIN = (bf16*)(ws + WS_WIN); bf16* WOUT = (bf16*)(ws + WS_WOUT);
    LAS float* scr = (LAS float*)(L + RING_OFF + wave * 16384); LAS float* part = (LAS float*)(L + RING_OFF + 7 * 16384 + 12288);
    constexpr int I_A = (NIN + 31) / 32, I_B = (D / 64) * (D / 32); const int gw = vcu * NWAVES + wave, NGW = G * NWAVES;
    for (int nb = vcu; nb < I_A; nb += G) fold_task(wi, D, NIN, NINP, WIN, RmMixIn(), lg, lb, true, (float*)(ws + WS_CSI), (float*)(ws + WS_BWI), scr, part, nb, wave, lane);
    for (int it = gw; it < I_B; it += NGW) transpose_item(wo, D, D, D, WOUT, RmId(), scr, it, lane);
}

__global__ void __launch_bounds__(NWAVES * 64, 2) hyb_fwd(Args args) {
    extern __shared__ __attribute__((aligned(16))) unsigned char lds[];
    LAS unsigned char* const L = (LAS unsigned char*)lds;
    for (int u = threadIdx.x; u < (LDS_BYTES - LDSCTL_OFF) / 4; u += NWAVES * 64) ((LAS unsigned*)(L + LDSCTL_OFF))[u] = 0u;
    __syncthreads();
    if (threadIdx.x == 0) { LAS unsigned long long* t = (LAS unsigned long long*)(L + PTAB_OFF);
#pragma unroll
        for (int i = 0; i < 23; ++i) t[i] = (unsigned long long)args.in[i];
        t[I_OUT] = (unsigned long long)args.out; t[I_WS] = (unsigned long long)args.ws; }
    __syncthreads();
    const int lo = args.ph_lo, hi = args.ph_hi;
    if (hi - lo > 1) (void)xcd_barrier_post((unsigned*)((gu32*)args.ws + CW_BAR), (volatile LAS unsigned*)(L + MISC_OFF) + 8);
#define IN(k) (lo <= (k) && (k) < hi)
#define SEAM(k) do { if ((k) + 1 < hi) { XcdBarrier b_; b_.bar = (unsigned*)ptab(I_WS) + CW_BAR; b_.x = xb_xcc_id(); b_.st = (volatile LAS unsigned*)(L + MISC_OFF) + 8; xcd_barrier(b_); } } while (0)

    if (IN(0)) {
        PH_BEGIN(); const int gt = vcu * (NWAVES * 64) + tid, NGT = G * NWAVES * 64;
        const int* pos = (const int*)ptab(I_POS); const float* x_in = PIN_F(I_X); float* ROPE = (float*)(ws + WS_ROPE); bf16* XB = (bf16*)(ws + WS_XB);
        for (int i = gt; i < M * 8; i += NGT) { const int r = i >> 3, k = i & 7;
            const float invf = (float)pow(500000.0, -(double)(2 * k) / 16.0);
            const float ang = (float)pos[r] * invf;
            ROPE[(size_t)r * 16 + k] = (float)cos((double)ang); ROPE[(size_t)r * 16 + 8 + k] = (float)sin((double)ang); }
        for (int r = gt; r < M; r += NGT) *(GAS f32x2*)((float*)(ws + WS_STATS) + 2 * (size_t)r) = (f32x2){0.f, 1.f};
        for (size_t i = (size_t)gt; i < (size_t)M * D / 4; i += NGT) { const f32x4 v = ((const GAS f32x4*)x_in)[i];
            const unsigned h01 = pk2(v.x, v.y), h23 = pk2(v.z, v.w);
            ((GAS unsigned long long*)XB)[i] = (unsigned long long)h01 | ((unsigned long long)h23 << 32);
            int lw_ = __builtin_amdgcn_cvt_pk_bf8_f32((v.x - bflo(h01)) * YLO_S, (v.y - bfhi(h01)) * YLO_S, 0, false); lw_ = __builtin_amdgcn_cvt_pk_bf8_f32((v.z - bflo(h23)) * YLO_S, (v.w - bfhi(h23)) * YLO_S, lw_, true);
            ((GAS unsigned*)(ws + WS_YLO))[i] = (unsigned)lw_; }
        convert_ffn(0, ws, L, vcu, G, wave, lane);
        SEAM(0);
    }

    for (int fi = 0; fi < NFFN; ++fi) {
        const int l = fi >> 1, second = fi & 1, pb = 1 + SLOTS * fi;
        if (fi > 0 && IN(pb + 0)) {
            PH_BEGIN();
            finalize_stats((const float*)(ws + WS_PS), (float*)(ws + WS_STATS), vcu * (NWAVES * 64) + tid, G * NWAVES * 64);
            SEAM(pb + 0);
        }
#pragma unroll 1
        for (int hf = 0; hf < FFN_SPLIT; ++hf) {
        if (IN(pb + 1)) {
            PH_BEGIN();
            pg8::Gemm g{(const bf16*)(ws + WS_XB), (const bf16*)(ws + WS_WFI), M, NFI, D}; pg8::StaticOrderOff S; S.init(M / FFN_SPLIT, NFI, G, bx_); S.pm0 = hf * (M / FFN_SPLIT / 256);
            pg8::EpiSwiGLU E{0};
            pg8::gemm_phase<pg8::EpiSwiGLU, pg8::StaticOrderOff, PG8_ALIGN, PG8_SP2>(L + RING_OFF, g, S, E);
            SEAM(pb + 1);
        }
        if (IN(pb + 2)) {
            PH_BEGIN();
            const bool hasln = fi > 0; const int lp = l > 0 ? l - 1 : 0;
            const bool conv_first = (vcu & 1) == 0, have_next = !second || l + 1 < DEPTH;
            if (conv_first && have_next) { if (!second) convert_mixer(l, ws, L, vcu, G, wave, lane); else convert_ffn(fi + 1, ws, L, vcu, G, wave, lane); VM_WAIT(); __syncthreads(); }
            { pg8::Gemm g{(const bf16*)(ws + WS_HP), (const bf16*)(ws + (second ? WS_WFO2 : WS_WFO)), M, D, DFF}; pg8::StaticOrderOff S; S.init(M / FFN_SPLIT, D, G, bx_); S.pm0 = hf * (M / FFN_SPLIT / 256);
            pg8::EpiResLN E{second ? (int)I_LN2G : (int)I_LN3G, second ? (int)I_LN2B : (int)I_LN3B, (second ? l : lp) * D, ALPHA, 0.5f, hasln};
            pg8::gemm_phase<pg8::EpiResLN, pg8::StaticOrderOff, PG8_ALIGN, PG8_SP2>(L + RING_OFF, g, S, E); }
            if (!conv_first && have_next) { VM_WAIT(); __syncthreads(); int w2_ = threadIdx.x; asm volatile("" : "+v"(w2_)); const int wave2 = __builtin_amdgcn_readfirstlane(w2_ >> 6), lane2 = w2_ & 63;
                if (!second) convert_mixer(l, ws, L, vcu, G, wave2, lane2); else convert_ffn(fi + 1, ws, L, vcu, G, wave2, lane2); }
            SEAM(pb + 2);
        }
        }
        if (second) continue;
        if (IN(pb + 4)) {
            PH_BEGIN();
            finalize_stats((const float*)(ws + WS_PS), (float*)(ws + WS_STATS), vcu * (NWAVES * 64) + tid, G * NWAVES * 64);
            SEAM(pb + 4);
        }
        if (IN(pb + 5)) {
            PH_BEGIN();
            { int ln_ = threadIdx.x; asm volatile("" : "+v"(ln_));
              for (int rb = vcu; rb < M / 128; rb += G)
                ba_rows((const bf16*)(ws + WS_XB), (const bf16*)(ws + WS_WIN) + (size_t)PW * D, (const float*)(ws + WS_STATS), (const float*)(ws + WS_CSI), (const float*)(ws + WS_BWI), (float*)(ws + WS_BA), rb * 128 + (ln_ >> 6) * 16, ln_ & 63); }
            pg8::Gemm g{(const bf16*)(ws + WS_XB), (const bf16*)(ws + WS_WIN), M, PW, D}; pg8::StaticOrder S; S.init(M, PW, G, bx_);
            pg8::EpiInProj E{QSCALE};
            pg8::gemm_phase<pg8::EpiInProj, pg8::StaticOrder, PG8_ALIGN, PG8_SP2>(L + RING_OFF, g, S, E);
            SEAM(pb + 5);
        }
        if (IN(pb + 6)) {
            { PH_BEGIN(); const float* cw = PIN_F(I_CONVW) + (size_t)l * 4 * 3072; const float aexp = __expf(PIN_F(I_ALOG)[l * NH + 0]);
            (void)aexp;
            for (int ci = vcu; ci < BATCH * NH * 32; ci += G) { const int h = (ci >> 5) & 7;
                gdn::g1_chunk(L + RING_OFF, tid, ci, (const bf16*)(ws + WS_HP), (const float*)(ws + WS_BA), cw, __expf(PIN_F(I_ALOG)[l * NH + h]), PIN_F(I_DTB)[l * NH + h], ws + WS_GDN + (size_t)ci * gdn::CHB, (float*)(ws + WS_CD)); }
            VM_WAIT(); __syncthreads(); }
            SEAM(pb + 6);
        }
        if (IN(pb + 7)) {
            PH_BEGIN();
            for (int v = vcu; v < 2 * BATCH * NH; v += G) { const int pair = v >> 1, b = pair >> 3, h = pair & 7; const unsigned qbmask = (v & 1) ? (0xFFu ^ X3_MASK0) : X3_MASK0;
                if (!(v & 1)) { int tid2_ = threadIdx.x; asm volatile("" : "+v"(tid2_)); gdn::g2_pair(L + RING_OFF, tid2_, pair, ws + WS_GDN, (const float*)(ws + WS_CD), (const bf16*)(ws + WS_HP), PIN_F(I_DELTAG) + l * 128, (bf16*)(ws + WS_MIX)); VM_WAIT(); __syncthreads(); }
                int ln_ = threadIdx.x & 63; asm volatile("" : "+v"(ln_));
                const float lam_init = 0.8f - 0.6f * expf(-0.3f * (float)l);
                const float lam_v = expf(wave_sum(PIN_F(I_LQ1)[l * 64 + ln_] * PIN_F(I_LK1)[l * 64 + ln_])) - expf(wave_sum(PIN_F(I_LQ2)[l * 64 + ln_] * PIN_F(I_LK2)[l * 64 + ln_])) + lam_init;
                const float lam = __builtin_bit_cast(float, __builtin_amdgcn_readfirstlane(__builtin_bit_cast(int, lam_v)));
                attn_body::attn_head_blocks<8>((char*)lds + RING_OFF, (const attn_body::bf16*)(ws + WS_HP), (attn_body::bf16*)(ws + WS_O), (attn_body::bf16*)(ws + WS_MIX), PIN_F(I_DIFFG) + l * 128, lam, 1.0f - lam_init, SUBLN_EPS, b, h, qbmask);
                VM_WAIT(); __syncthreads();
            }
            SEAM(pb + 7);
        }
        if (IN(pb + 9)) {
            PH_BEGIN();
            const bool conv_first = (vcu & 1) == 0;
            if (conv_first) { convert_ffn(fi + 1, ws, L, vcu, G, wave, lane); VM_WAIT(); __syncthreads(); }
            { pg8::Gemm g{(const bf16*)(ws + WS_MIX), (const bf16*)(ws + WS_WOUT), M, D, D}; pg8::StaticOrder S; S.init(M, D, G, bx_);
            pg8::EpiResLN E{(int)I_LN1G, (int)I_LN1B, l * D, ALPHA, 1.0f, true};
            pg8::gemm_phase<pg8::EpiResLN, pg8::StaticOrder, PG8_ALIGN, PG8_SP2>(L + RING_OFF, g, S, E); }
            if (!conv_first) { VM_WAIT(); __syncthreads(); int w2_ = threadIdx.x; asm volatile("" : "+v"(w2_)); convert_ffn(fi + 1, ws, L, vcu, G, __builtin_amdgcn_readfirstlane(w2_ >> 6), w2_ & 63); }
            SEAM(pb + 9);
        }
    }
    if (IN(NPH - 1)) {
        PH_BEGIN(); GWAVES(); float* XF = (float*)ptab(I_OUT); const float* PS = (const float*)(ws + WS_PS);
        const float* g3 = PIN_F(I_LN3G) + (size_t)(DEPTH - 1) * D; const float* b3 = PIN_F(I_LN3B) + (size_t)(DEPTH - 1) * D;
        for (int m = gw; m < M; m += NGW) final_ln_row(XF + (size_t)m * D, (const bf16*)(ws + WS_XB) + (size_t)m * D, (const unsigned char*)(ws + WS_YLO) + (size_t)m * D, PS + (size_t)m * 64, g3, b3, lane);
    }
#undef IN
#undef SEAM
}

extern "C" void kernel_launch(void* const* d_in, const int* in_sizes, int n_in, void* d_out, int out_size, void* d_ws, size_t ws_size, hipStream_t stream) {
    static int grid = 0;
    if (grid == 0) {
        if (n_in != 23 || in_sizes[0] != M * D || out_size != M * D || ws_size < WS_END) { fprintf(stderr, "kernel_launch: unexpected shapes (n_in %d, in0 %d, out %d, ws %zu); nothing launched\n", n_in, n_in > 0 ? in_sizes[0] : -1, out_size, ws_size); grid = -1; return; }
        int dev = 0, cus = 0, per_cu = 0;
        if (hipGetDevice(&dev) != hipSuccess || hipDeviceGetAttribute(&cus, hipDeviceAttributeMultiprocessorCount, dev) != hipSuccess) { grid = -1; return; }
        if (hipFuncSetAttribute((const void*)hyb_fwd, hipFuncAttributeMaxDynamicSharedMemorySize, LDS_BYTES) != hipSuccess) { fprintf(stderr, "kernel_launch: hipFuncSetAttribute failed\n"); grid = -1; return; }
        if (hipOccupancyMaxActiveBlocksPerMultiprocessor(&per_cu, (const void*)hyb_fwd, NWAVES * 64, LDS_BYTES) != hipSuccess || per_cu < 1) fprintf(stderr, "kernel_launch: occupancy query says %d\n", per_cu);
        (void)hipGetLastError();
        grid = cus;
    }
    if (grid < 0) return;
    if (hipMemsetAsync((char*)d_ws + WS_CTL, 0, CTL_ZERO_BYTES, stream) != hipSuccess) return;
    Args a{};
    for (int i = 0; i < 23; ++i) a.in[i] = d_in[i];
    a.out = (float*)d_out; a.ws = (unsigned char*)d_ws;
#if MK_ONE_LAUNCH
    a.ph_lo = 0; a.ph_hi = NPH;
    hipLaunchKernelGGL(hyb_fwd, dim3(grid), dim3(NWAVES * 64), LDS_BYTES, stream, a);
#else
    for (int ph = 0; ph < NPH; ++ph) {
        if (ph > 0 && ph < NPH - 1) { const int fi = (ph - 1) / SLOTS, slot = (ph - 1) % SLOTS; if (((fi & 1) && slot >= 4) || slot == 3 || slot == 8 || slot == 10) continue; }
        a.ph_lo = ph; a.ph_hi = ph + 1;
        hipLaunchKernelGGL(hyb_fwd, dim3(grid), dim3(NWAVES * 64), LDS_BYTES, stream, a);
    }
#endif
}
```

```cpp
#include <hip/hip_runtime.h>
constexpr int NWAVES = 8;
constexpr int BATCH = 16, SEQ = 2048, D = 2048, DEPTH = 4, M = BATCH * SEQ;
constexpr int DFF = 5632, NFI = 2 * DFF;
constexpr int NIN = 7184, NINP = 7424, PW = 7168;
constexpr int FFN_SPLIT = 1;
#ifndef X3_MASK0
#define X3_MASK0 0x1Du
#endif
constexpr int NH = 8;
constexpr float LN_EPS = 1e-5f, SUBLN_EPS = 1e-5f, GN_EPS = 1e-6f, L2_EPS = 1e-6f;
constexpr float ALPHA = 1.681792830507429f;
constexpr float QSCALE = 0.125f * 1.4426950408889634f;
constexpr int NFFN = 2 * DEPTH, SLOTS = 11, NPH = 2 + SLOTS * NFFN;

constexpr size_t MiB = 1u << 20;
constexpr size_t WS_CTL = 0, CTL_ZERO_BYTES = 1 * MiB;
constexpr size_t WS_ROPE = 1 * MiB, WS_BA = 3 * MiB, WS_CD = 5 * MiB, WS_STATS = 5 * MiB + 512 * 1024, WS_CSF = 6 * MiB, WS_BWF = 6 * MiB + 256 * 1024, WS_CSI = 6 * MiB + 512 * 1024, WS_BWI = 6 * MiB + 768 * 1024;
constexpr size_t WS_WFI = 8 * MiB, WS_WFO = 52 * MiB, WS_WIN = 74 * MiB, WS_WOUT = 103 * MiB;
constexpr size_t WS_XB = 112 * MiB, WS_MIX = 240 * MiB, WS_HP = 368 * MiB, WS_GDN = 816 * MiB, WS_O = 1104 * MiB, WS_PS = 1232 * MiB, WS_WFO2 = 1240 * MiB, WS_YLO = 1262 * MiB, WS_END = 1326 * MiB;
static_assert(WS_WFI + (size_t)NFI * D * 2 <= WS_WFO && WS_WFO + (size_t)D * DFF * 2 <= WS_WIN && WS_WIN + (size_t)NINP * D * 2 <= WS_WOUT && WS_WOUT + (size_t)D * D * 2 <= WS_XB, "weights map");
static_assert(WS_XB + (size_t)M * D * 2 <= WS_MIX && WS_MIX + (size_t)M * D * 2 <= WS_HP && WS_HP + (size_t)M * PW * 2 <= WS_GDN && WS_GDN + (size_t)4096 * 73728 <= WS_O && WS_O + (size_t)M * D * 2 <= WS_PS && WS_YLO + (size_t)M * D <= WS_END, "act map");
constexpr int CW_TMO = 0, CW_CODE = 1, CW_BAR = 4096;

constexpr int RING_OFF = 0, RING_BYTES = 131072;
constexpr int LDSCTL_OFF = RING_BYTES, MISC_OFF = LDSCTL_OFF + 320;
constexpr int LDS_BYTES = 147456;
static_assert(MISC_OFF + 128 <= LDS_BYTES, "LDS map");

#define GAS __attribute__((address_space(1)))
#define LAS __attribute__((address_space(3)))
enum { I_X = 0, I_POS, I_F1IN, I_F1OUT, I_LN1G, I_LN1B, I_WIN, I_CONVW, I_ALOG, I_DTB, I_LQ1, I_LK1, I_LQ2, I_LK2, I_DIFFG, I_DELTAG, I_WOUT, I_LN2G, I_LN2B, I_F2IN, I_F2OUT, I_LN3G, I_LN3B, I_OUT, I_WS };
constexpr int PTAB_OFF = LDSCTL_OFF + 512;
__device__ __forceinline__ unsigned char* ptab(int i) {
    extern __shared__ __attribute__((aligned(16))) unsigned char lds[];
    const LAS unsigned* t = (const LAS unsigned*)((LAS unsigned char*)lds + PTAB_OFF) + 2 * i;
    const unsigned lo = __builtin_amdgcn_readfirstlane(t[0]), hi = __builtin_amdgcn_readfirstlane(t[1]);
    return (unsigned char*)(GAS unsigned char*)(((unsigned long long)hi << 32) | lo);
}
constexpr int EPI_OFF = LDSCTL_OFF + 1024;
__device__ __forceinline__ LAS unsigned char* lds_base() { extern __shared__ __attribute__((aligned(16))) unsigned char lds[]; return (LAS unsigned char*)lds; }
__device__ __forceinline__ void epi_tables_dma(const float* stats, const float* ta, const float* tb, int row0, int col0, int wid, int lane) {
    if (wid < 4) { const float* src = wid < 2 ? stats + 2 * (size_t)(row0 + 128 * wid) : (wid == 2 ? ta : tb) + col0;
        __builtin_amdgcn_global_load_lds((const GAS unsigned*)(src + 4 * lane), (LAS unsigned*)(lds_base() + EPI_OFF + wid * 1024), 16, 0, 0); }
}
constexpr float YLO_S = 4096.0f, YLO_IS = 1.0f / 4096.0f;
#include <hip/hip_runtime.h>
#include <cstdio>
#include <cstdint>
namespace pg8 {
#define PG8_LAS __attribute__((address_space(3)))
typedef unsigned short bf16_t;
typedef short bf16x8 __attribute__((ext_vector_type(8)));
typedef float f32x4 __attribute__((ext_vector_type(4)));
typedef unsigned u32x4 __attribute__((ext_vector_type(4)));
constexpr int BM = 256, BK = 64, HALF = 128, HTB = HALF * BK * 2  , STAGE_BYTES = 8 * HTB, NXCD = 8, WGM = 8;

__host__ __device__ __forceinline__ int lds_byte(int r, int c) { const int st = (r >> 4) * 2 + (c >> 5), rr = r & 15, cc = c & 31, ob = rr * 64 + cc * 2; return st * 1024 + (ob ^ (((ob >> 9) & 1) << 5)); }
__host__ __device__ __forceinline__ void stage_rc(int b, int& R, int& C) { const int st = b / 1024, sb = b % 1024, swz = sb ^ (((sb >> 9) & 1) << 5); R = (st >> 1) * 16 + swz / 64; C = (st & 1) * 32 + (swz % 64) / 2; }
__host__ __device__ __forceinline__ int perm32(int rho) { const int n = rho >> 4, i = rho & 15; return 8 * (i >> 2) + 4 * n + (i & 3); }

struct Unit { int pm, pn; };
struct Gemm { const bf16_t* A; const bf16_t* Bt; int M, N, K; };

struct StaticOrder {
    int nM, nN, nwg, G, c;
    __host__ __device__ void init(int M, int N, int G_, int c_) { nM = M / BM; nN = N / BM; nwg = nM * nN; G = G_; c = c_; }
    __host__ __device__ bool next(int i, Unit& u) const {
        const long L = (long)i * G + c; if (L >= nwg) return false;
        int wgid = (int)L; { const int q = nwg / NXCD, r = nwg % NXCD, xcd = wgid % NXCD, off = wgid / NXCD; wgid = (xcd < r ? xcd * (q + 1) : r * (q + 1) + (xcd - r) * q) + off; }
        const int nig = WGM * nN, gid = wgid / nig, fm = gid * WGM, gsz = (nM - fm) < WGM ? (nM - fm) : WGM;
        u.pm = fm + ((wgid % nig) % gsz); u.pn = (wgid % nig) / gsz; return true;
    }
    __device__ __forceinline__ void a_ready(const Unit&) const {}
    __device__ __forceinline__ void done(const Unit&) const {}
};

struct StaticOrderOff : StaticOrder {
    int pm0;
    __host__ __device__ bool next(int i, Unit& u) const { const bool ok = StaticOrder::next(i, u); u.pm += pm0; return ok; }
};

__device__ __forceinline__ unsigned cvt_pk_bf16(float lo, float hi) { unsigned r; asm volatile("v_cvt_pk_bf16_f32 %0, %1, %2" : "=v"(r) : "v"(lo), "v"(hi)); return r; }
typedef float f32x2 __attribute__((ext_vector_type(2)));
__device__ __forceinline__ float silu_f(float g) { return g * __builtin_amdgcn_rcpf(1.0f + __builtin_amdgcn_exp2f(-1.4426950408889634f * g)); }
struct LnFold {
    __device__ __forceinline__ f32x2 st(int rowt) const { return *(const LAS f32x2*)(lds_base() + EPI_OFF + rowt * 8); }
    __device__ __forceinline__ void cols8(int colt, f32x4 (&cs)[2], f32x4 (&bw)[2]) const {
        const LAS unsigned char* p = lds_base() + EPI_OFF + 2048 + colt * 4;
        cs[0] = *(const LAS f32x4*)p; cs[1] = *(const LAS f32x4*)(p + 16); bw[0] = *(const LAS f32x4*)(p + 1024); bw[1] = *(const LAS f32x4*)(p + 1040); }
};
struct EpiSwiGLU {
    static constexpr bool PERM = true, AFTER_DRAIN = false;
    int pad_;
    __device__ __forceinline__ void pre(const Unit& u, int wid, int lane) const { unsigned char* const ws = ptab(I_WS); epi_tables_dma((const float*)(ws + WS_STATS), (const float*)(ws + WS_CSF), (const float*)(ws + WS_BWF), u.pm * BM, u.pn * BM, wid, lane); }
    __device__ __forceinline__ void operator()(const f32x4 (&acc)[2][2][4][2], const Unit& u, int wr, int wc, int fr, int fq) const {
        unsigned char* const ws = ptab(I_WS); bf16_t* const H = (bf16_t*)(ws + WS_HP); constexpr int ldh = DFF; const LnFold F{};
        const int rowt0 = wr * 64 + fr, row0 = u.pm * BM + rowt0, col0 = u.pn * HALF + wc * 32 + 8 * fq, wcol = wc * 32 + 8 * fq;
        f32x4 csg[2], bwg[2], csu[2], bwu[2]; F.cols8(wcol, csg, bwg); F.cols8(wcol + HALF, csu, bwu);
#pragma unroll
        for (int ai = 0; ai < 2; ++ai)
#pragma unroll
            for (int m = 0; m < 4; ++m) { const int row = row0 + ai * HALF + m * 16; bf16_t* rowp = H + (size_t)row * ldh + col0;
                const f32x2 st = F.st(rowt0 + ai * HALF + m * 16); const float mu = st.x, rs = st.y;
                const f32x4 g0 = (acc[ai][0][m][0] - csg[0] * mu) * rs + bwg[0], g1 = (acc[ai][0][m][1] - csg[1] * mu) * rs + bwg[1];
                const f32x4 u0 = (acc[ai][1][m][0] - csu[0] * mu) * rs + bwu[0], u1 = (acc[ai][1][m][1] - csu[1] * mu) * rs + bwu[1];
                u32x4 w; w.x = cvt_pk_bf16(silu_f(g0[0]) * u0[0], silu_f(g0[1]) * u0[1]); w.y = cvt_pk_bf16(silu_f(g0[2]) * u0[2], silu_f(g0[3]) * u0[3]);
                w.z = cvt_pk_bf16(silu_f(g1[0]) * u1[0], silu_f(g1[1]) * u1[1]); w.w = cvt_pk_bf16(silu_f(g1[2]) * u1[2], silu_f(g1[3]) * u1[3]);
                *(u32x4*)rowp = w; }
    }
};
struct EpiResLN {
    static constexpr bool PERM = true, AFTER_DRAIN = false;
    int ig, ib, loff; float alpha, s; bool hasln;
    static __device__ __forceinline__ float blo(unsigned w) { return __builtin_bit_cast(float, w << 16); }
    static __device__ __forceinline__ float bhi(unsigned w) { return __builtin_bit_cast(float, w & 0xffff0000u); }
    __device__ __forceinline__ void pre(const Unit& u, int wid, int lane) const { unsigned char* const ws = ptab(I_WS);
        epi_tables_dma((const float*)(ws + WS_STATS), (const float*)ptab(ig) + loff, (const float*)ptab(ib) + loff, u.pm * BM, u.pn * BM, wid, lane); }
    __device__ __forceinline__ void operator()(const f32x4 (&acc)[2][2][4][2], const Unit& u, int wr, int wc, int fr, int fq) const {
        unsigned char* const ws = ptab(I_WS); bf16_t* const YB = (bf16_t*)(ws + WS_XB); unsigned char* const YL = ws + WS_YLO; constexpr int ldc = D;
        float* const PS = (float*)(ws + WS_PS); const LnFold F{};
        const int rowt0 = wr * 64 + fr, row0 = u.pm * BM + rowt0, colt = wc * 32 + 8 * fq, col0 = u.pn * BM + colt;
        typedef unsigned u32x2_t __attribute__((ext_vector_type(2))); typedef float f32x2_t __attribute__((ext_vector_type(2)));
        u32x4 yh[3][2]; u32x2_t yl[3][2];
#define EPI_LOADG(buf, rg_) do { const size_t off_ = (size_t)(row0 + ((rg_) >> 2) * HALF + ((rg_) & 3) * 16) * ldc + col0; \
            _Pragma("unroll") for (int bj = 0; bj < 2; ++bj) { yh[buf][bj] = *(const u32x4*)(YB + off_ + bj * HALF); yl[buf][bj] = *(const u32x2_t*)(YL + off_ + bj * HALF); } } while (0)
        EPI_LOADG(0, 0); EPI_LOADG(1, 1);
#pragma unroll
        for (int rg = 0; rg < 8; ++rg) { const int ai = rg >> 2, m = rg & 3;
            if (rg + 2 < 8) { if ((rg + 2) % 3 == 0) EPI_LOADG(0, rg + 2); else if ((rg + 2) % 3 == 1) EPI_LOADG(1, rg + 2); else EPI_LOADG(2, rg + 2); }
            __builtin_amdgcn_sched_barrier(0);
            { const int row = row0 + ai * HALF + m * 16; const size_t off = (size_t)row * ldc + col0;
                const f32x2 st = F.st(rowt0 + ai * HALF + m * 16); const float mu = st.x, rs = st.y;
                float s1 = 0.f, s2 = 0.f;
#pragma unroll
                for (int bj = 0; bj < 2; ++bj) { f32x4 yn[2]; f32x4 gv[2], bv[2]; F.cols8(colt + bj * HALF, gv, bv);
                    if (!hasln) { gv[0] = (f32x4){1.f, 1.f, 1.f, 1.f}; gv[1] = gv[0]; bv[0] = (f32x4){0.f, 0.f, 0.f, 0.f}; bv[1] = bv[0]; }
#pragma unroll
                    for (int n = 0; n < 2; ++n) { const unsigned h0 = yh[rg % 3][bj][2 * n], h1 = yh[rg % 3][bj][2 * n + 1]; const int lw = (int)yl[rg % 3][bj][n];
                        const f32x2_t p0 = __builtin_amdgcn_cvt_pk_f32_bf8(lw, false), p1 = __builtin_amdgcn_cvt_pk_f32_bf8(lw, true);
                        const f32x4 yold = (f32x4){blo(h0) + p0.x * YLO_IS, bhi(h0) + p0.y * YLO_IS, blo(h1) + p1.x * YLO_IS, bhi(h1) + p1.y * YLO_IS};
                        const f32x4 xo = (yold - mu) * rs * gv[n] + bv[n]; yn[n] = xo * alpha + acc[ai][bj][m][n] * s;
                        s1 += (yn[n][0] + yn[n][1]) + (yn[n][2] + yn[n][3]); s2 += (yn[n][0] * yn[n][0] + yn[n][1] * yn[n][1]) + (yn[n][2] * yn[n][2] + yn[n][3] * yn[n][3]); }
                    u32x4 w; w.x = cvt_pk_bf16(yn[0][0], yn[0][1]); w.y = cvt_pk_bf16(yn[0][2], yn[0][3]); w.z = cvt_pk_bf16(yn[1][0], yn[1][1]); w.w = cvt_pk_bf16(yn[1][2], yn[1][3]);
                    int l0 = __builtin_amdgcn_cvt_pk_bf8_f32((yn[0][0] - blo(w.x)) * YLO_S, (yn[0][1] - bhi(w.x)) * YLO_S, 0, false); l0 = __builtin_amdgcn_cvt_pk_bf8_f32((yn[0][2] - blo(w.y)) * YLO_S, (yn[0][3] - bhi(w.y)) * YLO_S, l0, true);
                    int l1 = __builtin_amdgcn_cvt_pk_bf8_f32((yn[1][0] - blo(w.z)) * YLO_S, (yn[1][1] - bhi(w.z)) * YLO_S, 0, false); l1 = __builtin_amdgcn_cvt_pk_bf8_f32((yn[1][2] - blo(w.w)) * YLO_S, (yn[1][3] - bhi(w.w)) * YLO_S, l1, true);
                    *(u32x4*)(YB + off + bj * HALF) = w; *(u32x2_t*)(YL + off + bj * HALF) = (u32x2_t){(unsigned)l0, (unsigned)l1}; }
                s1 += __shfl_xor(s1, 16); s2 += __shfl_xor(s2, 16); s1 += __shfl_xor(s1, 32); s2 += __shfl_xor(s2, 32);
                if (fq == 0) *(f32x2*)(PS + ((size_t)row * 32 + 4 * u.pn + wc) * 2) = (f32x2){s1, s2}; }
            __builtin_amdgcn_sched_barrier(0);
        }
#undef EPI_LOADG
    }
};
struct EpiInProj {
    static constexpr bool PERM = true, AFTER_DRAIN = false;
    float qscale;
    __device__ __forceinline__ void pre(const Unit& u, int wid, int lane) const { unsigned char* const ws = ptab(I_WS); epi_tables_dma((const float*)(ws + WS_STATS), (const float*)(ws + WS_CSI), (const float*)(ws + WS_BWI), u.pm * BM, u.pn * BM, wid, lane); }
    __device__ __forceinline__ void operator()(const f32x4 (&acc)[2][2][4][2], const Unit& u, int wr, int wc, int fr, int fq) const {
        unsigned char* const ws = ptab(I_WS); bf16_t* const P = (bf16_t*)(ws + WS_HP); constexpr int ldp = PW; const float* const rope = (const float*)(ws + WS_ROPE);
        const LnFold F{};
        const int rowt0 = wr * 64 + fr, row0 = u.pm * BM + rowt0, wct = wc * 32 + 8 * fq, wcol = u.pn * BM + wct;
        const bool rot = (u.pn < 8) && ((wc & 1) == 0) && (fq < 2);
        const float sc = (u.pn < 4) ? qscale : 1.0f;
        f32x4 cs[2][2], bw[2][2]; F.cols8(wct, cs[0], bw[0]); F.cols8(wct + HALF, cs[1], bw[1]);
#pragma unroll
        for (int ai = 0; ai < 2; ++ai)
#pragma unroll
            for (int m = 0; m < 4; ++m) { const int row = row0 + ai * HALF + m * 16; bf16_t* rowp = P + (size_t)row * ldp + wcol;
                const f32x2 st = F.st(rowt0 + ai * HALF + m * 16);
                f32x4 cv = (f32x4){1.f, 1.f, 1.f, 1.f}, sn = (f32x4){0.f, 0.f, 0.f, 0.f};
                if (rot) { cv = *(const f32x4*)(rope + (size_t)row * 16 + 4 * fq); sn = *(const f32x4*)(rope + (size_t)row * 16 + 8 + 4 * fq); }
#pragma unroll
                for (int bj = 0; bj < 2; ++bj) { const f32x4 a = (acc[ai][bj][m][0] - cs[bj][0] * st.x) * st.y + bw[bj][0], b = (acc[ai][bj][m][1] - cs[bj][1] * st.x) * st.y + bw[bj][1];
                    const f32x4 v0 = (a * cv - b * sn) * sc, v1 = (b * cv + a * sn) * sc;
                    u32x4 w; w.x = cvt_pk_bf16(v0[0], v0[1]); w.y = cvt_pk_bf16(v0[2], v0[3]); w.z = cvt_pk_bf16(v1[0], v1[1]); w.w = cvt_pk_bf16(v1[2], v1[3]);
                    *(u32x4*)(rowp + bj * HALF) = w; } }
    }
};
template <class Epi, class Sched, bool ALIGN_EPI = false, bool SP2 = false>
__device__ __forceinline__ void gemm_phase(PG8_LAS unsigned char* lds, const Gemm g, const Sched& S, const Epi& E) {
    int tid_ = threadIdx.x; asm volatile("" : "+v"(tid_));
    const int tid = tid_, wid = __builtin_amdgcn_readfirstlane(tid >> 6), lane = tid & 63, wr = wid >> 2, wc = wid & 3, fr = lane & 15, fq = lane >> 4;
    const int K = g.K, nt = K / BK;
    unsigned voffA[2], voffB[2];
#pragma unroll
    for (int i = 0; i < 2; ++i) { int R, C; stage_rc(tid * 16 + i * 8192, R, C); const int Rb = Epi::PERM ? ((R & ~31) + perm32(R & 31)) : R;
        voffA[i] = (unsigned)(R * K + C) * 2u; voffB[i] = (unsigned)(Rb * K + C) * 2u; }
    const size_t kstep = (size_t)(BK * 2);
    const size_t hstep = (size_t)HALF * K * 2;
    const size_t tstep = 2 * hstep;
    const unsigned ldsw = (unsigned)wid * 1024u;
    const int aoff = lds_byte(wr * 64 + fr, fq * 8), boff = lds_byte(wc * 32 + fr, fq * 8);
#define PG8_SA(b, h) (((b) * 2 + (h)) * HTB)
#define PG8_SB(b, h) ((4 + (b) * 2 + (h)) * HTB)
#define PG8_STAGE(bufoff, gbase, voff) do { _Pragma("unroll") for (int _i = 0; _i < 2; ++_i) \
        __builtin_amdgcn_global_load_lds((const unsigned*)((const char*)(gbase) + (voff)[_i]), (PG8_LAS unsigned*)(lds + (bufoff) + ldsw + _i * 8192), 16, 0, 0); } while (0)
#define PG8_LDA(dst, b, h) do { _Pragma("unroll") for (int m = 0; m < 4; ++m) _Pragma("unroll") for (int k = 0; k < 2; ++k) dst[m][k] = *(const PG8_LAS bf16x8*)(lds + PG8_SA(b, h) + aoff + m * 2048 + k * 1024); } while (0)
#define PG8_LDB(dst, b, h) do { _Pragma("unroll") for (int n = 0; n < 2; ++n) _Pragma("unroll") for (int k = 0; k < 2; ++k) dst[n][k] = *(const PG8_LAS bf16x8*)(lds + PG8_SB(b, h) + boff + n * 2048 + k * 1024); } while (0)
#define PG8_MMA(ai, bj, At, Bt) do { __builtin_amdgcn_s_setprio(1); _Pragma("unroll") for (int m = 0; m < 4; ++m) _Pragma("unroll") for (int n = 0; n < 2; ++n) _Pragma("unroll") for (int k = 0; k < 2; ++k) \
        acc[ai][bj][m][n] = __builtin_amdgcn_mfma_f32_16x16x32_bf16(Bt[n][k], At[m][k], acc[ai][bj][m][n], 0, 0, 0); __builtin_amdgcn_s_setprio(0); } while (0)
#define PG8_WAIT_V(n) asm volatile("s_waitcnt vmcnt(" #n ")" ::: "memory")
#define PG8_WAIT_L(n) asm volatile("s_waitcnt lgkmcnt(" #n ")" ::: "memory")
#define PG8_BAR __builtin_amdgcn_s_barrier()
#define PG8_SCHED __builtin_amdgcn_sched_barrier(0)
    Unit cur, nxt; int ui = 0;
    if (!S.next(0, cur)) return;
    f32x4 acc[2][2][4][2];
#pragma unroll
    for (int a = 0; a < 2; ++a)
#pragma unroll
        for (int b = 0; b < 2; ++b)
#pragma unroll
            for (int m = 0; m < 4; ++m)
#pragma unroll
                for (int n = 0; n < 2; ++n) acc[a][b][m][n] = (f32x4){0.f, 0.f, 0.f, 0.f};
    bf16x8 At[4][2], B0[2][2], B1[2][2];
    const char* cA = (const char*)g.A + (size_t)cur.pm * tstep; const char* cB = (const char*)g.Bt + (size_t)cur.pn * tstep;
    S.a_ready(cur);
    if constexpr (SP2) {
        PG8_STAGE(PG8_SB(0, 0), cB, voffB); PG8_STAGE(PG8_SB(0, 1), cB + hstep, voffB); PG8_STAGE(PG8_SA(0, 0), cA, voffA); PG8_STAGE(PG8_SA(0, 1), cA + hstep, voffA);
        if (wr == 1) PG8_BAR;
        PG8_WAIT_V(2); PG8_BAR;
        PG8_STAGE(PG8_SB(1, 0), cB + kstep, voffB); PG8_STAGE(PG8_SA(1, 0), cA + kstep, voffA); PG8_STAGE(PG8_SB(1, 1), cB + hstep + kstep, voffB);
        PG8_WAIT_V(6); PG8_BAR;
    } else {
        PG8_STAGE(PG8_SB(0, 0), cB, voffB); PG8_STAGE(PG8_SA(0, 0), cA, voffA); PG8_STAGE(PG8_SB(0, 1), cB + hstep, voffB); PG8_STAGE(PG8_SA(0, 1), cA + hstep, voffA);
        if (wr == 1) PG8_BAR;
        PG8_WAIT_V(4); PG8_BAR;
        PG8_STAGE(PG8_SB(1, 0), cB + kstep, voffB); PG8_STAGE(PG8_SA(1, 0), cA + kstep, voffA); PG8_STAGE(PG8_SB(1, 1), cB + hstep + kstep, voffB);
        PG8_WAIT_V(6); PG8_BAR;
    }
    for (;;) {
        const bool has_next = S.next(ui + 1, nxt);
        const char* nA = has_next ? (const char*)g.A + (size_t)nxt.pm * tstep : cA; const char* nB = has_next ? (const char*)g.Bt + (size_t)nxt.pn * tstep : cB;
        for (int t = 0; t < nt; t += 2) {
            const bool last = (t == nt - 2);
            const char* a1 = cA + (size_t)(t + 1) * kstep;
            const char* a2 = last ? nA : cA + (size_t)(t + 2) * kstep; const char* b2 = last ? nB : cB + (size_t)(t + 2) * kstep;
            const char* a3 = a2 + kstep; const char* b3 = b2 + kstep;
            if (last && has_next) S.a_ready(nxt);
            if (last) E.pre(cur, wid, lane);
            if constexpr (SP2) {
            PG8_LDB(B0, 0, 0); PG8_LDB(B1, 0, 1); PG8_SCHED; PG8_LDA(At, 0, 0); PG8_STAGE(PG8_SA(1, 1), a1 + hstep, voffA);
            PG8_WAIT_V(8); PG8_WAIT_L(0); PG8_BAR; PG8_MMA(0, 0, At, B0); PG8_MMA(0, 1, At, B1); PG8_BAR; PG8_SCHED;
            PG8_LDA(At, 0, 1); PG8_STAGE(PG8_SB(0, 0), b2, voffB); PG8_STAGE(PG8_SB(0, 1), b2 + hstep, voffB); PG8_STAGE(PG8_SA(0, 0), a2, voffA);
            PG8_WAIT_V(8); PG8_WAIT_L(0); PG8_BAR; PG8_MMA(1, 0, At, B0); PG8_MMA(1, 1, At, B1); PG8_BAR; PG8_SCHED;
            PG8_LDB(B0, 1, 0); PG8_LDB(B1, 1, 1); PG8_SCHED; PG8_LDA(At, 1, 0); PG8_STAGE(PG8_SA(0, 1), a2 + hstep, voffA);
            PG8_WAIT_V(8); PG8_WAIT_L(0); PG8_BAR; PG8_MMA(0, 0, At, B0); PG8_MMA(0, 1, At, B1); PG8_BAR; PG8_SCHED;
            PG8_LDA(At, 1, 1); PG8_STAGE(PG8_SB(1, 0), b3, voffB); PG8_STAGE(PG8_SB(1, 1), b3 + hstep, voffB); PG8_STAGE(PG8_SA(1, 0), a3, voffA);
            PG8_WAIT_V(8); PG8_WAIT_L(0); PG8_BAR; PG8_MMA(1, 0, At, B0); PG8_MMA(1, 1, At, B1); PG8_BAR; PG8_SCHED;
            } else {
            PG8_LDB(B0, 0, 0); PG8_SCHED; PG8_LDA(At, 0, 0); PG8_STAGE(PG8_SA(1, 1), a1 + hstep, voffA);
            PG8_WAIT_L(8); PG8_BAR; PG8_WAIT_L(0); PG8_MMA(0, 0, At, B0); PG8_BAR; PG8_SCHED;
            PG8_LDB(B1, 0, 1); PG8_STAGE(PG8_SB(0, 0), b2, voffB);
            PG8_BAR; PG8_WAIT_L(0); PG8_MMA(0, 1, At, B1); PG8_BAR;
            PG8_LDA(At, 0, 1); PG8_STAGE(PG8_SA(0, 0), a2, voffA);
            PG8_BAR; PG8_WAIT_L(0); PG8_MMA(1, 0, At, B0); PG8_BAR; PG8_SCHED;
            PG8_STAGE(PG8_SB(0, 1), b2 + hstep, voffB);
            PG8_WAIT_V(6); PG8_BAR; PG8_MMA(1, 1, At, B1); PG8_BAR;
            PG8_LDB(B0, 1, 0); PG8_SCHED; PG8_LDA(At, 1, 0); PG8_STAGE(PG8_SA(0, 1), a2 + hstep, voffA);
            PG8_WAIT_L(8); PG8_BAR; PG8_WAIT_L(0); PG8_MMA(0, 0, At, B0); PG8_BAR; PG8_SCHED;
            PG8_LDB(B1, 1, 1); PG8_STAGE(PG8_SB(1, 0), b3, voffB);
            PG8_BAR; PG8_WAIT_L(0); PG8_MMA(0, 1, At, B1); PG8_BAR;
            PG8_LDA(At, 1, 1); PG8_STAGE(PG8_SA(1, 0), a3, voffA);
            PG8_BAR; PG8_WAIT_L(0); PG8_MMA(1, 0, At, B0); PG8_BAR; PG8_SCHED;
            PG8_STAGE(PG8_SB(1, 1), b3 + hstep, voffB);
            PG8_WAIT_V(6); PG8_BAR; PG8_MMA(1, 1, At, B1); PG8_BAR;
            }
        }
        if constexpr (ALIGN_EPI) { if (wr == 0) PG8_BAR; }
        if constexpr (!Epi::AFTER_DRAIN) { E(acc, cur, wr, wc, fr, fq); S.done(cur); }
        if (!has_next) break;
#pragma unroll
        for (int a = 0; a < 2; ++a)
#pragma unroll
            for (int b = 0; b < 2; ++b)
#pragma unroll
                for (int m = 0; m < 4; ++m)
#pragma unroll
                    for (int n = 0; n < 2; ++n) acc[a][b][m][n] = (f32x4){0.f, 0.f, 0.f, 0.f};
        cur = nxt; cA = nA; cB = nB; ++ui;
        if constexpr (ALIGN_EPI) { if (wr == 1) PG8_BAR; }
    }
    PG8_WAIT_V(0);
    if constexpr (!ALIGN_EPI) { if (wr == 0) PG8_BAR; }
    PG8_BAR;
    if constexpr (Epi::AFTER_DRAIN) { E.fused(acc, cur, wr, wc, fr, fq, lds, wid, lane); S.done(cur); }
#undef PG8_SA
#undef PG8_SB
#undef PG8_STAGE
#undef PG8_LDA
#undef PG8_LDB
#undef PG8_MMA
#undef PG8_WAIT_V
#undef PG8_WAIT_L
#undef PG8_BAR
#undef PG8_SCHED
}
}

#ifndef PG8_SP2
#define PG8_SP2 true
#endif
#ifndef PG8_ALIGN
#define PG8_ALIGN true
#endif
#include <hip/hip_bf16.h>
#include <cmath>
namespace attn_body {
using bf16=__hip_bfloat16;
using bf16x8=__attribute__((ext_vector_type(8)))short;
using s16x4=__attribute__((ext_vector_type(4)))short;
using f32x16=__attribute__((ext_vector_type(16)))float;
using u32x4=__attribute__((ext_vector_type(4)))unsigned;
constexpr int SEQ=2048,D=64,QKVP=7168,OPITCH=2048;
constexpr int NW=8,QBLK=32,QB=QBLK*NW,KVBLK=64,NQB=SEQ/QB;
constexpr int ATTN_UNIT_ROWS=QB;
__device__ __forceinline__ int crow(int r,int hi){return (r&3)+8*(r>>2)+4*hi;}
#define SBAR() __builtin_amdgcn_sched_barrier(0)
__device__ __forceinline__ void cmask(f32x16&p0,f32x16&p1,int jb,int qrel,int hi){
  const float NEG=-INFINITY; int kb=64*jb+4*hi;
  #pragma unroll
  for(int r=0;r<16;++r){int kv=kb+(r&3)+8*(r>>2); if(kv>qrel)p0[r]=NEG; if(kv+32>qrel)p1[r]=NEG;}
}

constexpr int NSLOT=3, SLOTB=8192;
constexpr int LDS_K=0, LDS_V=NSLOT*SLOTB, LDS_WS=3*NSLOT*SLOTB, LDS_OST=LDS_WS+NW*64*4, LDS_BYTES=LDS_OST+NW*4096;
constexpr float C2=0.125f*1.4426950408889634f;
__device__ __forceinline__ void glds16(const void*gsrc,unsigned lds_dst){unsigned keep;
  asm volatile("s_mov_b32 %0, m0\n\ts_mov_b32 m0, %2\n\ts_nop 0\n\tglobal_load_lds_dwordx4 %1, off\n\ts_mov_b32 m0, %0":"=&s"(keep):"v"(gsrc),"s"(lds_dst):"memory");}
__device__ __forceinline__ float max3f(float a,float b,float c){float r;asm("v_max3_f32 %0, %1, %2, %3":"=v"(r):"v"(a),"v"(b),"v"(c));return r;}
__device__ __forceinline__ float max2f(float a,float b){float r;asm("v_max_f32_e32 %0, %1, %2":"=v"(r):"v"(a),"v"(b));return r;}
__device__ __forceinline__ float fadd_s(float a,float b){float r;asm("v_add_f32_e32 %0, %1, %2":"=v"(r):"v"(a),"v"(b));return r;}
__device__ __forceinline__ float fsub_s(float a,float b){float r;asm("v_sub_f32_e32 %0, %1, %2":"=v"(r):"v"(a),"v"(b));return r;}
typedef float f32x2_t __attribute__((ext_vector_type(2))); typedef __bf16 bf16x2_t __attribute__((ext_vector_type(2)));
__device__ __forceinline__ unsigned cvtpk_s(float lo,float hi){f32x2_t v={lo,hi};bf16x2_t b=__builtin_convertvector(v,bf16x2_t);return __builtin_bit_cast(unsigned,b);}
#define WAIT_BAR(N) asm volatile("s_waitcnt vmcnt(" #N ") lgkmcnt(0)\n\ts_barrier":::"memory")

__device__ __forceinline__ void qkt(f32x16&p0,f32x16&p1,const char*Kslot,const bf16x8*qr,const f32x16&negm,int r32,int hi){
  const char*kb=Kslot+hi*1024+r32*16;
  #pragma unroll
  for(int d0=0;d0<4;++d0){
    const bf16x8 b0=*reinterpret_cast<const bf16x8*>(kb+d0*2048);
    const bf16x8 b1=*reinterpret_cast<const bf16x8*>(kb+d0*2048+512);
    if(d0==0){p0=__builtin_amdgcn_mfma_f32_32x32x16_bf16(b0,qr[0],negm,0,0,0);p1=__builtin_amdgcn_mfma_f32_32x32x16_bf16(b1,qr[0],negm,0,0,0);}
    else{p0=__builtin_amdgcn_mfma_f32_32x32x16_bf16(b0,qr[d0],p0,0,0,0);p1=__builtin_amdgcn_mfma_f32_32x32x16_bf16(b1,qr[d0],p1,0,0,0);}}
}
typedef __attribute__((address_space(3))) const char* lds_cptr;
typedef short v4i16_t __attribute__((ext_vector_type(4)));
__device__ __forceinline__ void kload8(bf16x8*kf,lds_cptr kp){
  kf[0]=*(const __attribute__((address_space(3))) bf16x8*)(kp);      kf[1]=*(const __attribute__((address_space(3))) bf16x8*)(kp+512);
  kf[2]=*(const __attribute__((address_space(3))) bf16x8*)(kp+2048); kf[3]=*(const __attribute__((address_space(3))) bf16x8*)(kp+2560);
  kf[4]=*(const __attribute__((address_space(3))) bf16x8*)(kp+4096); kf[5]=*(const __attribute__((address_space(3))) bf16x8*)(kp+4608);
  kf[6]=*(const __attribute__((address_space(3))) bf16x8*)(kp+6144); kf[7]=*(const __attribute__((address_space(3))) bf16x8*)(kp+6656);
}
__device__ __forceinline__ void kload2(bf16x8*kf,lds_cptr kp,int j){ kf[2*j]=*(const __attribute__((address_space(3))) bf16x8*)(kp+j*2048); kf[2*j+1]=*(const __attribute__((address_space(3))) bf16x8*)(kp+j*2048+512); }
__device__ __forceinline__ s16x4 vtr(lds_cptr p){ return __builtin_bit_cast(s16x4,__builtin_amdgcn_ds_read_tr16_b64_v4i16((__attribute__((address_space(3))) v4i16_t*)p)); }
__device__ __forceinline__ float rowmax(const f32x16&p0,const f32x16&p1){
  float a=max3f(p0[0],p0[1],p1[0]),b=max3f(p0[2],p0[3],p1[1]);a=max3f(a,p1[2],p1[3]);
  #pragma unroll
  for(int r=4;r<16;r+=4){a=max3f(a,p0[r],p0[r+1]);b=max3f(b,p0[r+2],p0[r+3]);a=max3f(a,p1[r],p1[r+1]);b=max3f(b,p1[r+2],p1[r+3]);}
  const float m=max2f(a,b);
  auto rr=__builtin_amdgcn_permlane32_swap(__float_as_uint(m),__float_as_uint(m),false,false);
  return max2f(__uint_as_float(rr[0]),__uint_as_float(rr[1]));
}
__device__ __forceinline__ void pv(f32x16*o,int vb,bf16x8 pa0,bf16x8 pa1,bf16x8 pa2,bf16x8 pa3){
  #pragma unroll
  for(int d0=0;d0<4;++d0){s16x4 lo[4],hi[4];
    #pragma unroll
    for(int ks=0;ks<4;++ks){
      asm volatile("ds_read_b64_tr_b16 %0,%1 offset:%c2":"=&v"(lo[ks]):"v"(vb),"i"(d0*4096+ks*1024):"memory");
      asm volatile("ds_read_b64_tr_b16 %0,%1 offset:%c2":"=&v"(hi[ks]):"v"(vb),"i"(d0*4096+ks*1024+512):"memory");}
    asm volatile("s_waitcnt lgkmcnt(0)":::"memory");SBAR();
    #define PK(k) (bf16x8){lo[k][0],lo[k][1],lo[k][2],lo[k][3],hi[k][0],hi[k][1],hi[k][2],hi[k][3]}
    o[d0]=__builtin_amdgcn_mfma_f32_32x32x16_bf16(pa0,PK(0),o[d0],0,0,0);
    o[d0]=__builtin_amdgcn_mfma_f32_32x32x16_bf16(pa1,PK(1),o[d0],0,0,0);
    o[d0]=__builtin_amdgcn_mfma_f32_32x32x16_bf16(pa2,PK(2),o[d0],0,0,0);
    o[d0]=__builtin_amdgcn_mfma_f32_32x32x16_bf16(pa3,PK(3),o[d0],0,0,0);
    #undef PK
  }
}

#ifndef ATTN_STORE16
#define ATTN_STORE16(p,v) (*(u32x4*)(p)=(v))
#endif
template<int THRL> __device__ __forceinline__ void attn_unit(int b,int h,int qb,const bf16*Q,const bf16*__restrict__ K,const bf16*__restrict__ V,bf16*O,char*shm,int mode,const bf16*O1,bf16*MIXp,const float*dg,float lam,float oml,float sub_eps){
  int tid_=threadIdx.x; asm volatile("":"+v"(tid_)); const int tid=tid_,lane=tid&63,r32=lane&31,hi=lane>>5; const int wid=__builtin_amdgcn_readfirstlane(tid>>6);
  const long rowbase=(long)b*SEQ; const int q0=qb*QB;
  const bf16*Qw=Q+(rowbase+q0+wid*QBLK)*QKVP;
  const bf16*Kh=K+rowbase*QKVP,*Vh=V+rowbase*QKVP;
  const unsigned lds0=(unsigned)(uintptr_t)shm;
  float*wsf=(float*)(shm+LDS_WS)+wid*64;
  const bf16*ksrc=Kh+(long)lane*QKVP+wid*8;
  const bf16*vsrc=Vh+(long)(16*(wid&3)+(lane>>2))*QKVP+(wid>>2)*32+(lane&3)*8;
  const unsigned kdst=lds0+LDS_K+wid*1024, vdst=lds0+LDS_V+wid*1024;
  #define DMA_K(t,slot) glds16(ksrc+(long)(t)*KVBLK*QKVP,(unsigned)__builtin_amdgcn_readfirstlane(kdst+(slot)))
  #define DMA_V(t,slot) do{ glds16(vsrc+(long)(t)*KVBLK*QKVP,(unsigned)__builtin_amdgcn_readfirstlane(vdst+2*(slot))); glds16(vsrc+(long)(t)*KVBLK*QKVP+64,(unsigned)__builtin_amdgcn_readfirstlane(vdst+2*(slot)+8192)); }while(0)
  const int vb0=(int)(lds0+LDS_V)+((lane>>4)&1)*32+(lane&3)*8+(4*hi+((lane&15)>>2))*64;
  const char*Kbase=shm+LDS_K; bf16x8 kf[8];
  const lds_cptr shm3=(lds_cptr)shm; const lds_cptr kp0=shm3+LDS_K+hi*1024+r32*16; const lds_cptr vp0=shm3+LDS_V+((lane>>4)&1)*32+(lane&3)*8+(4*hi+((lane&15)>>2))*64;
  const int NT=(q0+QB)/KVBLK;
  DMA_K(0,0);DMA_V(0,0);DMA_K(1,SLOTB);
  bf16x8 qr[4];
  #pragma unroll
  for(int d0=0;d0<4;++d0)qr[d0]=*reinterpret_cast<const bf16x8*>(&Qw[(long)r32*QKVP+d0*16+hi*8]);
  float mhat=0.f,l_reg=0.f;f32x16 o[4];o[0]=f32x16{};o[1]=f32x16{};o[2]=f32x16{};o[3]=f32x16{};f32x16 negm=f32x16{};asm volatile("":"+v"(negm));
  const int qrel=wid*QBLK+r32;
  #define CMASK(P0,P1,t) do{int jb_=(t)-(NT-4); if(jb_>=0)cmask(P0,P1,jb_,qrel,hi);}while(0)
  bool resc=false;
  #define START(P0,P1) do{ const float rm=rowmax(P0,P1); resc=false; \
    { const float dl=rm; mhat=fadd_s(mhat,dl); \
      _Pragma("unroll") for(int r=0;r<16;++r){P0[r]=fsub_s(P0[r],dl);P1[r]=fsub_s(P1[r],dl);} \
      _Pragma("unroll") for(int r=0;r<16;++r)negm[r]=-mhat; asm volatile("":"+v"(negm)); } \
    _Pragma("unroll") for(int r=0;r<16;++r)P0[r]=__builtin_amdgcn_exp2f(P0[r]); }while(0)
  #define RESC() do{ if(resc){ asm volatile("s_waitcnt lgkmcnt(0)":::"memory"); \
      _Pragma("unroll") for(int d_=0;d_<4;++d_) _Pragma("unroll") for(int r=0;r<16;++r)o[d_][r]*=wsf[crow(r,hi)]; } }while(0)
  f32x16 pA0,pA1,pB0,pB1;
  int sl_prev=0,sl_cur=0,sl_next=SLOTB;
  #define ROT() do{sl_prev=sl_cur;sl_cur=sl_next;sl_next=(sl_next==(NSLOT-1)*SLOTB)?0:sl_next+SLOTB;}while(0)
  DMA_K(2,2*SLOTB);
  WAIT_BAR(3);
  qkt(pA0,pA1,Kbase,qr,negm,r32,hi);asm volatile("s_nop 15\n\ts_nop 7":"+v"(pA0),"+v"(pA1));CMASK(pA0,pA1,0);
  START(pA0,pA1);
  _Pragma("unroll") for(int r=0;r<16;++r)pA1[r]=__builtin_amdgcn_exp2f(pA1[r]);
  WAIT_BAR(0);
  DMA_K(3,0);DMA_V(1,SLOTB);
  ROT();
  kload8(kf,kp0+sl_cur);
  WAIT_BAR(3);
  s16x4 vlo[4],vhi[4]; u32x4 pw0,pw1,pw2,pw3;
  #define PKW(P,B) cvtpk_s(P[B],P[B+1])
  #define PAF(k) __builtin_bit_cast(bf16x8,pw##k)
  #define VFR(i) (bf16x8){vlo[(i)&3][0],vlo[(i)&3][1],vlo[(i)&3][2],vlo[(i)&3][3],vhi[(i)&3][0],vhi[(i)&3][1],vhi[(i)&3][2],vhi[(i)&3][3]}
  #define PIN(x) asm volatile("":"+v"(x))
  #define MX3(a,b,c) __builtin_fmaxf(__builtin_fmaxf((a),(b)),(c))
  #define GAPA(MF,A0,A1,A2,A3,W0,W1,PW) do{ MF; sacc+=A0; sacc+=A1; sacc+=A2; sacc+=A3; PIN(sacc); W0; W1; PIN(PW); SBAR(); }while(0)
  #define EX(v) __builtin_amdgcn_exp2f(v)
  #define VRD(n) do{ vlo[(n)&3]=vtr(vp_+(((n)&3)*4096+((n)>>2)*1024)); vhi[(n)&3]=vtr(vp_+(((n)&3)*4096+((n)>>2)*1024+512)); }while(0)
  #define GAPB(n,KS,X,B) do{ o[(n)&3]=__builtin_amdgcn_mfma_f32_32x32x16_bf16(PAF(KS),VFR(n),o[(n)&3],0,0,0); if((n)+4<16){VRD((n)+4);} X[B]=EX(X[B]); X[B+1]=EX(X[B+1]); PIN(X); SBAR(); }while(0)
  #define KRD(G,j) do{ if(G){ kload2(kf,kp0+sl_next,j); SBAR(); } }while(0)
  #define STEP(C0,C1,P0,P1,t,GK,GV,GL) do{ SBAR(); \
    const lds_cptr vp_=vp0+2*sl_prev; \
    float sacc=(P0[0]+P0[1]); \
    GAPA(C0=__builtin_amdgcn_mfma_f32_32x32x16_bf16(kf[0],qr[0],negm,0,0,0), P0[2],P0[3],P0[4],P0[5],     pw0[0]=PKW(P0,0), pw0[1]=PKW(P0,2), pw0); \
    GAPA(C1=__builtin_amdgcn_mfma_f32_32x32x16_bf16(kf[1],qr[0],negm,0,0,0), P0[6],P0[7],P0[8],P0[9],     pw0[2]=PKW(P0,4), pw0[3]=PKW(P0,6), pw0); \
    GAPA(C0=__builtin_amdgcn_mfma_f32_32x32x16_bf16(kf[2],qr[1],C0,0,0,0),   P0[10],P0[11],P0[12],P0[13], pw1[0]=PKW(P0,8), pw1[1]=PKW(P0,10), pw1); \
    GAPA(C1=__builtin_amdgcn_mfma_f32_32x32x16_bf16(kf[3],qr[1],C1,0,0,0),   P0[14],P0[15],P1[0],P1[1],   pw1[2]=PKW(P0,12),pw1[3]=PKW(P0,14), pw1); \
    VRD(0); SBAR(); GAPA(C0=__builtin_amdgcn_mfma_f32_32x32x16_bf16(kf[4],qr[2],C0,0,0,0),   P1[2],P1[3],P1[4],P1[5],     pw2[0]=PKW(P1,0), pw2[1]=PKW(P1,2), pw2); \
    VRD(1); SBAR(); GAPA(C1=__builtin_amdgcn_mfma_f32_32x32x16_bf16(kf[5],qr[2],C1,0,0,0),   P1[6],P1[7],P1[8],P1[9],     pw2[2]=PKW(P1,4), pw2[3]=PKW(P1,6), pw2); \
    VRD(2); SBAR(); GAPA(C0=__builtin_amdgcn_mfma_f32_32x32x16_bf16(kf[6],qr[3],C0,0,0,0),   P1[10],P1[11],P1[12],P1[13], pw3[0]=PKW(P1,8), pw3[1]=PKW(P1,10), pw3); \
    VRD(3); SBAR(); GAPA(C1=__builtin_amdgcn_mfma_f32_32x32x16_bf16(kf[7],qr[3],C1,0,0,0),   P1[14],P1[15],0.f,0.f,       pw3[2]=PKW(P1,12),pw3[3]=PKW(P1,14), pw3); \
    l_reg+=sacc; \
    if(GK){DMA_K((t)+3,sl_cur);} if(GV){DMA_V((t)+1,sl_next);} \
    CMASK(C0,C1,t); \
    { float a=MX3(C0[0],C0[1],C1[0]),b=MX3(C0[2],C0[3],C1[1]); a=MX3(a,C1[2],C1[3]); \
      _Pragma("unroll") for(int r=4;r<16;r+=4){a=MX3(a,C0[r],C0[r+1]);b=MX3(b,C0[r+2],C0[r+3]);a=MX3(a,C1[r],C1[r+1]);b=MX3(b,C1[r+2],C1[r+3]);} \
      float rm=__builtin_fmaxf(a,b); { auto rr=__builtin_amdgcn_permlane32_swap(__float_as_uint(rm),__float_as_uint(rm),false,false); rm=__builtin_fmaxf(__uint_as_float(rr[0]),__uint_as_float(rr[1])); } \
      resc=false; \
      if(__builtin_expect(__any(rm>(float)THRL),0)){ const float dl=__builtin_fmaxf(rm,0.f); mhat+=dl; \
        _Pragma("unroll") for(int r=0;r<16;++r){C0[r]-=dl;C1[r]-=dl;} \
        _Pragma("unroll") for(int r=0;r<16;++r)negm[r]=-mhat; asm volatile("":"+v"(negm)); \
        const float f=__builtin_amdgcn_exp2f(-dl); l_reg*=f; if(hi==0)wsf[r32]=f; resc=true; } } \
    SBAR(); \
    GAPB(0,0,C0,0);  GAPB(1,0,C0,2);  GAPB(2,0,C0,4);   GAPB(3,0,C0,6); \
    GAPB(4,1,C0,8);  GAPB(5,1,C0,10); GAPB(6,1,C0,12);  GAPB(7,1,C0,14); \
    KRD(GL,0); GAPB(8,2,C1,0);  KRD(GL,1); GAPB(9,2,C1,2);  KRD(GL,2); GAPB(10,2,C1,4);  KRD(GL,3); GAPB(11,2,C1,6); \
    GAPB(12,3,C1,8); GAPB(13,3,C1,10); GAPB(14,3,C1,12); GAPB(15,3,C1,14); \
    }while(0)
  int t=1;
  #undef CMASK
  #define CMASK(P0,P1,t) do{}while(0)
  for(;t+5<NT;t+=2){
    STEP(pB0,pB1,pA0,pA1,t,true,true,true);     WAIT_BAR(3); RESC(); ROT();
    STEP(pA0,pA1,pB0,pB1,t+1,true,true,true);   WAIT_BAR(3); RESC(); ROT();
  }
  #undef CMASK
  #define CMASK(P0,P1,t) do{int jb_=(t)-(NT-4); if(jb_>=0)cmask(P0,P1,jb_,qrel,hi);}while(0)
  #define ENDW(tt) do{ if((tt)+3<NT){WAIT_BAR(3);} else if((tt)+2<NT){WAIT_BAR(2);} else {WAIT_BAR(0);} }while(0)
  for(;t+1<NT;t+=2){
    STEP(pB0,pB1,pA0,pA1,t,(t+3<NT),(t+1<NT),(t+1<NT));       ENDW(t);   RESC(); ROT();
    STEP(pA0,pA1,pB0,pB1,t+1,(t+4<NT),(t+2<NT),(t+2<NT));     ENDW(t+1); RESC(); ROT();
  }
  STEP(pB0,pB1,pA0,pA1,NT-1,false,false,false); RESC();
  { float sacc=pB0[0]+pB0[1]; _Pragma("unroll") for(int r=2;r<16;++r)sacc+=pB0[r]; _Pragma("unroll") for(int r=0;r<16;++r)sacc+=pB1[r]; l_reg+=sacc;
    pw0=(u32x4){PKW(pB0,0),PKW(pB0,2),PKW(pB0,4),PKW(pB0,6)};pw1=(u32x4){PKW(pB0,8),PKW(pB0,10),PKW(pB0,12),PKW(pB0,14)};pw2=(u32x4){PKW(pB1,0),PKW(pB1,2),PKW(pB1,4),PKW(pB1,6)};pw3=(u32x4){PKW(pB1,8),PKW(pB1,10),PKW(pB1,12),PKW(pB1,14)};
    SBAR(); pv(o,vb0+2*sl_cur,PAF(0),PAF(1),PAF(2),PAF(3)); }
  #undef PKW
  #undef PAF
  #undef VFR
  #undef PIN
  #undef MX3
  #undef GAPA
  #undef GAPB
  #undef EX
  #undef VRD
  #undef KRD
  #undef STEP
  #undef ENDW
  {auto rr=__builtin_amdgcn_permlane32_swap(__float_as_uint(l_reg),__float_as_uint(l_reg),false,false);l_reg=__uint_as_float(rr[0])+__uint_as_float(rr[1]);}
  if(hi==0)wsf[32+r32]=l_reg;asm volatile("s_waitcnt lgkmcnt(0)":::"memory");
  float rli[16];
  #pragma unroll
  for(int r=0;r<16;++r)rli[r]=__builtin_amdgcn_rcpf(wsf[32+crow(r,hi)]);
  { bf16*stg=(bf16*)(shm+LDS_OST)+wid*2048;
    const long wrow=(rowbase+q0+wid*QBLK)*OPITCH;
    #define ATTN_STAGE(hp) do{ _Pragma("unroll") for(int r=0;r<16;++r){const int orow=crow(r,hi); \
        _Pragma("unroll") for(int d0=0;d0<2;++d0)stg[orow*64+d0*32+r32]=__float2bfloat16(o[2*(hp)+d0][r]*rli[r]);} \
      asm volatile("s_waitcnt lgkmcnt(0)":::"memory"); }while(0)
    if(mode==0){ bf16*Ow=O+wrow;
      #pragma unroll
      for(int hp=0;hp<2;++hp){ ATTN_STAGE(hp);
        #pragma unroll
        for(int i=0;i<4;++i){const int row=i*8+(lane>>3),ch=lane&7; const u32x4 v=*(const u32x4*)(stg+row*64+ch*8); ATTN_STORE16(Ow+(long)row*OPITCH+hp*64+ch*8,v);}
        asm volatile("s_waitcnt lgkmcnt(0)":::"memory"); }
    } else { const bf16*O1w=O1+wrow; bf16*Mw=MIXp+wrow; const int ch=lane&7;
      float dv[2][4][8]; float ss[4]={0.f,0.f,0.f,0.f};
      #define BLO(w_) __uint_as_float((w_)<<16)
      #define BHI(w_) __uint_as_float((w_)&0xffff0000u)
      #pragma unroll
      for(int hp=0;hp<2;++hp){ ATTN_STAGE(hp);
        #pragma unroll
        for(int i=0;i<4;++i){const int row=i*8+(lane>>3); const u32x4 v=*(const u32x4*)(stg+row*64+ch*8); const u32x4 a1=*(const u32x4*)(O1w+(long)row*OPITCH+hp*64+ch*8);
          dv[hp][i][0]=BLO(a1[0])-lam*BLO(v[0]); dv[hp][i][1]=BHI(a1[0])-lam*BHI(v[0]); dv[hp][i][2]=BLO(a1[1])-lam*BLO(v[1]); dv[hp][i][3]=BHI(a1[1])-lam*BHI(v[1]);
          dv[hp][i][4]=BLO(a1[2])-lam*BLO(v[2]); dv[hp][i][5]=BHI(a1[2])-lam*BHI(v[2]); dv[hp][i][6]=BLO(a1[3])-lam*BLO(v[3]); dv[hp][i][7]=BHI(a1[3])-lam*BHI(v[3]);
          #pragma unroll
          for(int e=0;e<8;++e)ss[i]+=dv[hp][i][e]*dv[hp][i][e]; }
        asm volatile("s_waitcnt lgkmcnt(0)":::"memory"); }
      #undef BLO
      #undef BHI
      #pragma unroll
      for(int i=0;i<4;++i){ ss[i]+=__shfl_xor(ss[i],1); ss[i]+=__shfl_xor(ss[i],2); ss[i]+=__shfl_xor(ss[i],4); ss[i]=1.0f/sqrtf(ss[i]*(1.f/128.f)+sub_eps); }
      #pragma unroll
      for(int hp=0;hp<2;++hp){ float g[8];
        #pragma unroll
        for(int e=0;e<8;++e)g[e]=dg[hp*64+ch*8+e]*oml;
        #pragma unroll
        for(int i=0;i<4;++i){const int row=i*8+(lane>>3); const float rn=ss[i]; u32x4 w;
          w[0]=cvtpk_s(dv[hp][i][0]*rn*g[0],dv[hp][i][1]*rn*g[1]); w[1]=cvtpk_s(dv[hp][i][2]*rn*g[2],dv[hp][i][3]*rn*g[3]); w[2]=cvtpk_s(dv[hp][i][4]*rn*g[4],dv[hp][i][5]*rn*g[5]); w[3]=cvtpk_s(dv[hp][i][6]*rn*g[6],dv[hp][i][7]*rn*g[7]);
          ATTN_STORE16(Mw+(long)row*OPITCH+hp*64+ch*8,w);} } }
    #undef ATTN_STAGE
  }
  asm volatile("s_waitcnt lgkmcnt(0)\n\ts_barrier":::"memory");
  #undef DMA_K
  #undef DMA_V
  #undef CMASK
  #undef START
  #undef RESC
  #undef ROT
}
constexpr int ATTN_LDS_BYTES=LDS_BYTES;
template<int THRL=8> __device__ __forceinline__ void attn_head_blocks(char*lds,const bf16*P,bf16*O1,bf16*MIX,const float*dg,float lam,float oml,float sub_eps,int b,int h,unsigned qbmask){
  for(int qb=7;qb>=0;--qb){ if(!((qbmask>>qb)&1u))continue;
    #pragma unroll 1
    for(int c=0;c<2;++c)
      attn_unit<THRL>(b,0,qb,P+(h*2+c)*64,P+1024+(h*2+c)*64,P+2048+h*128,O1+(h*2)*128,lds,c,O1+(h*2)*128,MIX+h*128,dg,lam,oml,sub_eps); }
}
#undef SBAR
#undef WAIT_BAR
}
#define GAS __attribute__((address_space(1)))
#define LAS __attribute__((address_space(3)))
typedef unsigned short bf16;
typedef unsigned v4u __attribute__((ext_vector_type(4)));
typedef float f32x4 __attribute__((ext_vector_type(4)));
typedef short bf16x8 __attribute__((ext_vector_type(8)));
typedef GAS unsigned gu32;
typedef GAS unsigned long long gu64;
#define RLX_AGENT __ATOMIC_RELAXED, __HIP_MEMORY_SCOPE_AGENT
#define LDS_WAIT() asm volatile("s_waitcnt lgkmcnt(0)" ::: "memory")
#define VM_WAIT() asm volatile("s_waitcnt vmcnt(0)" ::: "memory")
__device__ __forceinline__ unsigned long long rt() { return __builtin_amdgcn_s_memrealtime(); }
__device__ __forceinline__ unsigned f2bf(float f) { unsigned u = __builtin_bit_cast(unsigned, f); return (u + 0x7fffu + ((u >> 16) & 1u)) >> 16; }
__device__ __forceinline__ unsigned pk2(float lo, float hi) { return f2bf(lo) | (f2bf(hi) << 16); }

#define XB_TMO      128
#define XB_XCNT(j)  (256  + 64 * (j))
#define XB_XSUB(j)  (1280 + 64 * (j))
#define XB_XGEN(j)  (2304 + 64 * (j))
#define XB_TOP      3328
#define XB_TOPGEN   3392
#define XCD_BAR_WORDS 3456
#define XB_SPIN_CAP (1u << 18)

__device__ __forceinline__ unsigned xb_ld(unsigned* p)              { return __hip_atomic_load(p, __ATOMIC_RELAXED, __HIP_MEMORY_SCOPE_AGENT); }
__device__ __forceinline__ unsigned xb_add(unsigned* p, unsigned v) { return __hip_atomic_fetch_add(p, v, __ATOMIC_RELAXED, __HIP_MEMORY_SCOPE_AGENT); }
__device__ __forceinline__ unsigned xb_xcc_id() { return (unsigned)__builtin_amdgcn_s_getreg((3 << 11) | 20) & 0xFu; }
#define XB_SPIN(cond, bar) do { unsigned _sp = 0; while (cond) { __builtin_amdgcn_s_sleep(1); \
    if ((++_sp & 255u) == 0u) { if (xb_ld(&(bar)[XB_TMO])) break; if (_sp > XB_SPIN_CAP) { atomicAdd(&(bar)[XB_TMO], 1u); break; } } } } while (0)

struct XcdBarrier {
    unsigned* bar; unsigned x;
    volatile LAS unsigned* st;
};

__device__ __forceinline__ XcdBarrier xcd_barrier_post(unsigned* bar, volatile LAS unsigned* st) {
    XcdBarrier b; b.bar = bar; b.x = xb_xcc_id(); b.st = st;
    if (threadIdx.x == 0) (void)xb_add(&bar[XB_XCNT(b.x)], 1u);
    return b;
}
__device__ __forceinline__ void xcd_barrier_complete(unsigned* bar, unsigned x, unsigned& nloc, unsigned& nx) {
    const unsigned G = gridDim.x * gridDim.y * gridDim.z;
    unsigned sum, cnt, mine, sp = 0u;
    for (;;) {
        sum = 0u; cnt = 0u; mine = 0u;
#pragma unroll
        for (unsigned j = 0; j < 16; ++j) { const unsigned c = xb_ld(&bar[XB_XCNT(j)]); sum += c; cnt += (c > 0u) ? 1u : 0u; mine = (j == x) ? c : mine; }
        if (sum == G) break;
        __builtin_amdgcn_s_sleep(1);
        if ((++sp & 255u) == 0u) { if (xb_ld(&bar[XB_TMO])) break; if (sp > XB_SPIN_CAP) { atomicAdd(&bar[XB_TMO], 1u); break; } }
    }
    nloc = mine > 0u ? mine : 1u; nx = cnt > 0u ? cnt : 1u;
}

__device__ __forceinline__ void xcd_barrier(const XcdBarrier& b) {
    asm volatile("s_waitcnt vmcnt(0)" ::: "memory");
    __syncthreads();
    if (threadIdx.x == 0) {
        unsigned* bar = b.bar;
        __builtin_amdgcn_s_waitcnt(0);
        unsigned nloc = b.st[0], nx = b.st[1];
        if (nloc == 0u) { xcd_barrier_complete(bar, b.x, nloc, nx); b.st[0] = nloc; b.st[1] = nx; }
        const unsigned old = xb_add(&bar[XB_XSUB(b.x)], 1u);
        const unsigned gen = old / nloc;
        if (old + 1u == (gen + 1u) * nloc) {
            __builtin_amdgcn_fence(__ATOMIC_RELEASE, "agent");
            asm volatile("s_waitcnt vmcnt(0)" ::: "memory");
            const unsigned og = xb_add(&bar[XB_TOP], 1u);
            const unsigned tg = og / nx;
            if (og + 1u == (tg + 1u) * nx) xb_add(&bar[XB_TOPGEN], 1u);
            else XB_SPIN(xb_ld(&bar[XB_TOPGEN]) == tg, bar);
            __builtin_amdgcn_fence(__ATOMIC_ACQUIRE, "agent");
            xb_add(&bar[XB_XGEN(b.x)], 1u);
            asm volatile("s_waitcnt vmcnt(0)" ::: "memory");
        } else {
            XB_SPIN(xb_ld(&bar[XB_XGEN(b.x)]) == gen, bar);
            __builtin_amdgcn_fence(__ATOMIC_ACQUIRE, "agent");
            asm volatile("s_waitcnt vmcnt(0)" ::: "memory");
        }
    }
    __syncthreads();
}
#ifndef MK_ONE_LAUNCH
#define MK_ONE_LAUNCH 1
#endif
typedef float f32x2 __attribute__((ext_vector_type(2)));
__device__ __forceinline__ float wave_sum(float v) {
#pragma unroll
    for (int o = 1; o < 64; o <<= 1) v += __shfl_xor(v, o);
    return v;
}
__device__ __forceinline__ float bf2f(unsigned short h) { return __builtin_bit_cast(float, (unsigned)h << 16); }
__device__ __forceinline__ float bflo(unsigned w) { return __builtin_bit_cast(float, w << 16); }
__device__ __forceinline__ float bfhi(unsigned w) { return __builtin_bit_cast(float, w & 0xffff0000u); }
__device__ __forceinline__ float silu(float g) { return g * __builtin_amdgcn_rcpf(1.0f + __expf(-g)); }

template <class RowMap>
__device__ __forceinline__ void transpose_item(const float* W, int K, int N, int NP, bf16* WT, const RowMap& rm, LAS float* scr, int item, int lane) {
    const int nblk = NP / 32, kb = item / nblk, nb = item % nblk, k0 = 64 * kb, n0 = 32 * nb;
    const int r8 = lane >> 3, c4 = lane & 7; const bool ok = n0 + 4 * c4 < N;
    f32x4 v[8];
#pragma unroll
    for (int i = 0; i < 8; ++i) v[i] = ok ? *(const GAS f32x4*)(W + (size_t)(k0 + r8 + 8 * i) * N + n0 + 4 * c4) : (f32x4){0.f, 0.f, 0.f, 0.f};
#pragma unroll
    for (int i = 0; i < 8; ++i) { LAS float* d = scr + (r8 + 8 * i) * 33 + 4 * c4; d[0] = v[i].x; d[1] = v[i].y; d[2] = v[i].z; d[3] = v[i].w; }
    LDS_WAIT(); asm volatile("" ::: "memory");
    const int c = lane & 7;
#pragma unroll
    for (int j = 0; j < 4; ++j) { const int n = (lane >> 3) + 8 * j; const LAS float* s = scr + (8 * c) * 33 + n;
        v4u o; o.x = pk2(s[0 * 33], s[1 * 33]); o.y = pk2(s[2 * 33], s[3 * 33]); o.z = pk2(s[4 * 33], s[5 * 33]); o.w = pk2(s[6 * 33], s[7 * 33]);
        *(GAS v4u*)(WT + (size_t)rm(n0 + n) * K + k0 + 8 * c) = o; }
    LDS_WAIT(); asm volatile("" ::: "memory");
}
struct RmId { __device__ __forceinline__ int operator()(int n) const { return n; } };
struct RmFfnIn { __device__ __forceinline__ int operator()(int n) const { const int up = n >= DFF, j = n - up * DFF; return (j >> 7) * 256 + up * 128 + (j & 127); } };
struct RmMixIn { __device__ __forceinline__ int operator()(int n) const { if (n >= 2048) return n; const int p = n & 63; if (p >= 4 && p < 12) return (n & ~63) + (p ^ 12); return n; } };

__device__ __forceinline__ void ln_row(const float* yrow, float* xrow, bf16* brow, const float* g, const float* b, int lane) {
    const GAS f32x4* yr = (const GAS f32x4*)yrow + lane;
    f32x4 v[8]; float s = 0.f;
#pragma unroll
    for (int j = 0; j < 8; ++j) { v[j] = yr[64 * j]; s += (v[j].x + v[j].y) + (v[j].z + v[j].w); }
    const float mean = wave_sum(s) * (1.f / D); float s2 = 0.f;
#pragma unroll
    for (int j = 0; j < 8; ++j) { v[j] = v[j] - mean; s2 += (v[j].x * v[j].x + v[j].y * v[j].y) + (v[j].z * v[j].z + v[j].w * v[j].w); }
    const float rstd = 1.f / sqrtf(wave_sum(s2) * (1.f / D) + LN_EPS);
    GAS f32x4* xo = (GAS f32x4*)xrow + lane; GAS unsigned long long* o8 = (GAS unsigned long long*)brow + lane;
    const GAS f32x4* gp = (const GAS f32x4*)g + lane; const GAS f32x4* bp = (const GAS f32x4*)b + lane;
#pragma unroll
    for (int j = 0; j < 8; ++j) { const f32x4 o = v[j] * rstd * gp[64 * j] + bp[64 * j]; xo[64 * j] = o;
        o8[64 * j] = (unsigned long long)pk2(o.x, o.y) | ((unsigned long long)pk2(o.z, o.w) << 32); }
}

template <class RowMap>
__device__ __forceinline__ void fold_task(const float* W, int K, int N, int NP, bf16* WT, const RowMap& rm, const float* g, const float* b, bool hasln, float* cs, float* bw, LAS float* scr, LAS float* part, int nb, int wave, int lane) {
    const int n0 = 32 * nb, kbn = K / 512, kb0 = wave * kbn;
    const int r8 = lane >> 3, c4 = lane & 7; const bool ok = n0 + 4 * c4 < N; const int c = lane & 7;
    float pcs[4] = {0.f, 0.f, 0.f, 0.f}, pbw[4] = {0.f, 0.f, 0.f, 0.f};
    f32x4 cur[8];
#pragma unroll
    for (int i = 0; i < 8; ++i) cur[i] = ok ? *(const GAS f32x4*)(W + (size_t)(64 * kb0 + r8 + 8 * i) * N + n0 + 4 * c4) : (f32x4){0.f, 0.f, 0.f, 0.f};
#pragma unroll 1
    for (int kb = kb0; kb < kb0 + kbn; ++kb) { const int k0 = 64 * kb;
#pragma unroll
        for (int i = 0; i < 8; ++i) { LAS float* d = scr + (r8 + 8 * i) * 33 + 4 * c4; d[0] = cur[i].x; d[1] = cur[i].y; d[2] = cur[i].z; d[3] = cur[i].w; }
        if (kb + 1 < kb0 + kbn) {
#pragma unroll
            for (int i = 0; i < 8; ++i) cur[i] = ok ? *(const GAS f32x4*)(W + (size_t)(k0 + 64 + r8 + 8 * i) * N + n0 + 4 * c4) : (f32x4){0.f, 0.f, 0.f, 0.f}; }
        f32x4 g0 = *(const GAS f32x4*)(g + k0 + 8 * c), g1 = *(const GAS f32x4*)(g + k0 + 8 * c + 4), b0 = *(const GAS f32x4*)(b + k0 + 8 * c), b1 = *(const GAS f32x4*)(b + k0 + 8 * c + 4);
        if (!hasln) { g0 = (f32x4){1.f, 1.f, 1.f, 1.f}; g1 = g0; b0 = (f32x4){0.f, 0.f, 0.f, 0.f}; b1 = b0; }
        LDS_WAIT(); asm volatile("" ::: "memory");
#pragma unroll
        for (int j = 0; j < 4; ++j) { const int n = (lane >> 3) + 8 * j; const LAS float* s = scr + (8 * c) * 33 + n;
            const float s0 = s[0], s1 = s[33], s2 = s[66], s3 = s[99], s4 = s[132], s5 = s[165], s6 = s[198], s7 = s[231];
            v4u o; o.x = pk2(s0 * g0.x, s1 * g0.y); o.y = pk2(s2 * g0.z, s3 * g0.w); o.z = pk2(s4 * g1.x, s5 * g1.y); o.w = pk2(s6 * g1.z, s7 * g1.w);
            *(GAS v4u*)(WT + (size_t)rm(n0 + n) * K + k0 + 8 * c) = o;
            pcs[j] += ((bflo(o.x) + bfhi(o.x)) + (bflo(o.y) + bfhi(o.y))) + ((bflo(o.z) + bfhi(o.z)) + (bflo(o.w) + bfhi(o.w)));
            pbw[j] += ((s0 * b0.x + s1 * b0.y) + (s2 * b0.z + s3 * b0.w)) + ((s4 * b1.x + s5 * b1.y) + (s6 * b1.z + s7 * b1.w)); }
        LDS_WAIT(); asm volatile("" ::: "memory");
    }
#pragma unroll
    for (int j = 0; j < 4; ++j) { float a = pcs[j], d = pbw[j];
        a += __shfl_xor(a, 1); d += __shfl_xor(d, 1); a += __shfl_xor(a, 2); d += __shfl_xor(d, 2); a += __shfl_xor(a, 4); d += __shfl_xor(d, 4);
        if (c == 0) { const int n = (lane >> 3) + 8 * j; part[(wave * 32 + n) * 2] = a; part[(wave * 32 + n) * 2 + 1] = d; } }
    __syncthreads();
    if (wave == 0 && lane < 32) { float a = 0.f, d = 0.f;
#pragma unroll
        for (int w = 0; w < 8; ++w) { a += part[(w * 32 + lane) * 2]; d += part[(w * 32 + lane) * 2 + 1]; }
        const int r = rm(n0 + lane); cs[r] = a; bw[r] = d; }
    __syncthreads();
}
__device__ __forceinline__ void finalize_stats(const float* PS, float* stats, int gt, int ngt) {
    const int q = gt & 15;
    for (int r = gt >> 4; r < M; r += ngt >> 4) { const f32x4 v = *((const GAS f32x4*)(PS + (size_t)r * 64) + q); float s1 = v.x + v.z, s2 = v.y + v.w;
        s1 += __shfl_xor(s1, 1); s2 += __shfl_xor(s2, 1); s1 += __shfl_xor(s1, 2); s2 += __shfl_xor(s2, 2); s1 += __shfl_xor(s1, 4); s2 += __shfl_xor(s2, 4); s1 += __shfl_xor(s1, 8); s2 += __shfl_xor(s2, 8);
        const float mu = s1 * (1.f / D), var = fmaxf(s2 * (1.f / D) - mu * mu, 0.f);
        if (q == 0) *(GAS f32x2*)(stats + 2 * (size_t)r) = (f32x2){mu, 1.0f / sqrtf(var + LN_EPS)}; }
}
__device__ __forceinline__ void final_ln_row(float* orow, const bf16* hrow, const unsigned char* lrow, const float* psrow, const float* g, const float* b, int lane) {
    const f32x2 pv = *(const GAS f32x2*)(psrow + 2 * (lane & 31)); float s1 = pv.x, s2 = pv.y;
#pragma unroll
    for (int o = 1; o < 32; o <<= 1) { s1 += __shfl_xor(s1, o); s2 += __shfl_xor(s2, o); }
    const float mu = s1 * (1.f / D), rstd = 1.0f / sqrtf(fmaxf(s2 * (1.f / D) - mu * mu, 0.f) + LN_EPS);
    typedef unsigned u32x2_ __attribute__((ext_vector_type(2)));
    GAS f32x4* yr = (GAS f32x4*)orow + lane; const GAS f32x4* gp = (const GAS f32x4*)g + lane; const GAS f32x4* bp = (const GAS f32x4*)b + lane;
    const GAS u32x2_* hp = (const GAS u32x2_*)hrow + lane; const GAS unsigned* lp = (const GAS unsigned*)lrow + lane;
    u32x2_ vh[8]; unsigned vl[8];
#pragma unroll
    for (int j = 0; j < 8; ++j) { vh[j] = hp[64 * j]; vl[j] = lp[64 * j]; }
#pragma unroll
    for (int j = 0; j < 8; ++j) { const f32x2 p0 = __builtin_amdgcn_cvt_pk_f32_bf8((int)vl[j], false), p1 = __builtin_amdgcn_cvt_pk_f32_bf8((int)vl[j], true);
        const f32x4 v = (f32x4){bflo(vh[j].x) + p0.x * YLO_IS, bfhi(vh[j].x) + p0.y * YLO_IS, bflo(vh[j].y) + p1.x * YLO_IS, bfhi(vh[j].y) + p1.y * YLO_IS};
        yr[64 * j] = (v - mu) * rstd * gp[64 * j] + bp[64 * j]; }
}
namespace gdn {
typedef float f32x16 __attribute__((ext_vector_type(16)));
typedef float f32x2_t __attribute__((ext_vector_type(2))); typedef __bf16 bf16x2_t __attribute__((ext_vector_type(2)));
typedef unsigned u32x2 __attribute__((ext_vector_type(2)));
__device__ __forceinline__ unsigned cvtpk(float lo, float hi) { f32x2_t v = {lo, hi}; bf16x2_t b = __builtin_convertvector(v, bf16x2_t); return __builtin_bit_cast(unsigned, b); }
__device__ __forceinline__ int crow(int r, int hi) { return (r & 3) + 8 * (r >> 2) + 4 * hi; }
template <int S_> __device__ __forceinline__ bf16x8 packB(const f32x16& x) { v4u p; p.x = cvtpk(x[8 * S_], x[8 * S_ + 1]); p.y = cvtpk(x[8 * S_ + 2], x[8 * S_ + 3]); p.z = cvtpk(x[8 * S_ + 4], x[8 * S_ + 5]); p.w = cvtpk(x[8 * S_ + 6], x[8 * S_ + 7]); return __builtin_bit_cast(bf16x8, p); }
#define GDN_MFMA(a, b, c) __builtin_amdgcn_mfma_f32_32x32x16_bf16((a), (b), (c), 0, 0, 0)
constexpr int OFF_W = 0, OFF_QD = 16384, OFF_KDT = 32768, OFF_AT = 49152, OFF_U = 57344, CHB = 73728, ABYTES = 55296;
constexpr int G2_OT = 2 * ABYTES, OTP = 272;
constexpr int TP = 272, ATP = 144;
constexpr int L_QT = 0, L_KT = 17408, L_VT = 34816, L_WT = 52224, L_LT = 69632, L_AT = 86016, L_GC = 95232, L_BETA = L_GC + 256, L_BE = L_BETA + 256, L_EG = L_BE + 256, L_EGL = L_EG + 256, L_END = L_EGL + 256;

__device__ __forceinline__ void exp_frag(const LAS unsigned char* tile, int pitch, int rowbase, int kb, const LAS float* rowscale, GAS v4u* dst, int lane) {
    const int r32 = lane & 31, hi = lane >> 5, row = rowbase + r32;
    const LAS unsigned char* p = tile + row * pitch + (kb + 4 * hi) * 2;
    u32x2 a = *(const LAS u32x2*)p, b = *(const LAS u32x2*)(p + 16);
    if (rowscale) { const float sc = rowscale[row];
        a.x = cvtpk(bflo(a.x) * sc, bfhi(a.x) * sc); a.y = cvtpk(bflo(a.y) * sc, bfhi(a.y) * sc); b.x = cvtpk(bflo(b.x) * sc, bfhi(b.x) * sc); b.y = cvtpk(bflo(b.y) * sc, bfhi(b.y) * sc); }
    v4u o; o.x = a.x; o.y = a.y; o.z = b.x; o.w = b.y; dst[lane] = o;
}

__device__ __forceinline__ void g1_chunk(LAS unsigned char* L, int tid, int ci, const bf16* P, const float* BA, const float* cw, float aexp, float dtb, unsigned char* blk, float* CD) {
    const int lane = tid & 63, wave = __builtin_amdgcn_readfirstlane(tid >> 6), r32 = lane & 31, hi = lane >> 5;
    const int n = ci & 31, h = (ci >> 5) & 7, b = ci >> 8, r0 = b * SEQ + 64 * n;
    LAS float* GC = (LAS float*)(L + L_GC); LAS float* BETA = (LAS float*)(L + L_BETA); LAS float* BE = (LAS float*)(L + L_BE); LAS float* EG = (LAS float*)(L + L_EG); LAS float* EGL = (LAS float*)(L + L_EGL);
    float db_pre = 0.f, da_pre = 0.f; if (wave == 0) { const size_t r = (size_t)(r0 + lane); db_pre = BA[r * 16 + h]; da_pre = BA[r * 16 + 8 + h]; }
    {   const int rowq = 4 * wave + (lane >> 4), c16 = lane & 15;
#pragma unroll 1
        for (int half = 0; half < 2; ++half) {
        v4u raw[3][4]; const int row = 32 * half + rowq, s = 64 * n + row;
#pragma unroll
        for (int sec = 0; sec < 3; ++sec) { const int chl = sec * 1024 + h * 128 + 8 * c16;
#pragma unroll
            for (int j = 0; j < 4; ++j) raw[sec][j] = (s - 3 + j >= 0) ? *(const GAS v4u*)(P + (size_t)(r0 + row - 3 + j) * PW + 3072 + chl) : (v4u){0u, 0u, 0u, 0u}; }
        __builtin_amdgcn_sched_barrier(0);
#pragma unroll
        for (int sec = 0; sec < 3; ++sec) {
            float a[8];
#pragma unroll
            for (int e = 0; e < 8; ++e) a[e] = 0.f;
#pragma unroll
            for (int j = 0; j < 4; ++j) { const v4u w = raw[sec][j]; const int chl = sec * 1024 + h * 128 + 8 * c16; const f32x4 c0 = *(const GAS f32x4*)(cw + j * 3072 + chl), c1 = *(const GAS f32x4*)(cw + j * 3072 + chl + 4);
                a[0] += c0.x * bflo(w.x); a[1] += c0.y * bfhi(w.x); a[2] += c0.z * bflo(w.y); a[3] += c0.w * bfhi(w.y);
                a[4] += c1.x * bflo(w.z); a[5] += c1.y * bfhi(w.z); a[6] += c1.z * bflo(w.w); a[7] += c1.w * bfhi(w.w); }
            float ss = 0.f;
#pragma unroll
            for (int e = 0; e < 8; ++e) { a[e] = silu(a[e]); ss += a[e] * a[e]; }
            if (sec < 2) { ss += __shfl_xor(ss, 1); ss += __shfl_xor(ss, 2); ss += __shfl_xor(ss, 4); ss += __shfl_xor(ss, 8);
                float rn = 1.0f / sqrtf(ss + L2_EPS); if (sec == 0) rn *= 0.08838834764831845f;
#pragma unroll
                for (int e = 0; e < 8; ++e) a[e] *= rn; }
            v4u o; o.x = cvtpk(a[0], a[1]); o.y = cvtpk(a[2], a[3]); o.z = cvtpk(a[4], a[5]); o.w = cvtpk(a[6], a[7]);
            *(LAS v4u*)(L + sec * 17408 + row * TP + c16 * 16) = o; }
        }
    }
    if (wave == 0) { const float db = db_pre, da = da_pre + dtb;
        const float ee = __expf(da); const float sp = da > 15.f ? da : (ee < 1e-3f ? ee * (1.0f - 0.5f * ee) : __logf(1.0f + ee));   float x = -aexp * sp;
#pragma unroll
        for (int off = 1; off < 64; off <<= 1) { const float t = __shfl_up(x, off); if (lane >= off) x += t; }
        const float gl = __shfl(x, 63), bt = 1.0f / (1.0f + __expf(-db)), eg = __expf(x);
        GC[lane] = x; BETA[lane] = bt; BE[lane] = bt * eg; EG[lane] = eg; EGL[lane] = __expf(gl - x);
        if (lane == 63) CD[ci] = eg; }
    LDS_WAIT(); __builtin_amdgcn_s_barrier(); asm volatile("" ::: "memory");
    if (wave < 6) { const int type = wave / 3, t = wave - 3 * type, ti = t >= 1, tj = t == 2;
        const LAS unsigned char* Ab = L + (type ? L_QT : L_KT) + (32 * ti + r32) * TP + hi * 16; const LAS unsigned char* Bb = L + L_KT + (32 * tj + r32) * TP + hi * 16;
        f32x16 acc;
#pragma unroll
        for (int r = 0; r < 16; ++r) acc[r] = 0.f;
#pragma unroll
        for (int ks = 0; ks < 8; ++ks) acc = GDN_MFMA(*(const LAS bf16x8*)(Ab + ks * 32), *(const LAS bf16x8*)(Bb + ks * 32), acc);
        const int j = 32 * tj + r32; const float gj = GC[j];
#pragma unroll
        for (int r = 0; r < 16; ++r) { const int i = 32 * ti + crow(r, hi); const float d = __expf(GC[i] - gj);
            if (type == 0) ((LAS float*)(L + L_LT))[i * 64 + j] = (i > j) ? acc[r] * BETA[i] * d : 0.f;
            else *(LAS unsigned short*)(L + L_AT + i * ATP + j * 2) = (unsigned short)f2bf((i >= j) ? acc[r] * d : 0.f); }
    }
    LDS_WAIT(); __builtin_amdgcn_s_barrier(); asm volatile("" ::: "memory");
    if (wave < 4) {
        const int col = tid & 127; const bool isW = wave >= 2;
        unsigned ltb = L_LT, rsb = isW ? L_BE : L_BETA; asm volatile("" : "+v"(ltb), "+v"(rsb));
        const LAS unsigned char* src = L + (isW ? L_KT : L_VT) + col * 2; const LAS float* rs = (const LAS float*)(L + rsb); const LAS float* LT = (const LAS float*)(L + ltb);
        float x[64];
#pragma unroll
        for (int i = 0; i < 64; ++i) x[i] = bf2f(*(const LAS unsigned short*)(src + i * TP)) * rs[i];
        f32x4 lr[2][14];
        lr[1][0] = *(const LAS f32x4*)(LT + 64);
#pragma unroll
        for (int i = 1; i < 64; ++i) {
            if (i + 1 < 64) {
#pragma unroll
                for (int jj = 0; jj < (i + 4) / 4 && jj < 14; ++jj) lr[(i + 1) & 1][jj] = *(const LAS f32x4*)(LT + (i + 1) * 64 + 4 * jj); }
            __builtin_amdgcn_sched_barrier(0);
            float a0 = x[i], a1 = 0.f, a2 = 0.f, a3 = 0.f;
#pragma unroll
            for (int jj = 0; jj < (i + 3) / 4; ++jj) { const f32x4 l4 = jj < 14 ? lr[i & 1][jj] : *(const LAS f32x4*)(LT + i * 64 + 4 * jj);
                a0 -= l4.x * x[4 * jj]; if (4 * jj + 1 < i) a1 -= l4.y * x[4 * jj + 1]; if (4 * jj + 2 < i) a2 -= l4.z * x[4 * jj + 2]; if (4 * jj + 3 < i) a3 -= l4.w * x[4 * jj + 3]; }
            x[i] = (a0 + a1) + (a2 + a3);
            __builtin_amdgcn_sched_barrier(0);
        }
        if (!isW) { const int dvt = col >> 5, c32 = col & 31;
#pragma unroll
            for (int ct = 0; ct < 2; ++ct)
#pragma unroll
                for (int hh = 0; hh < 2; ++hh) { GAS v4u* d = (GAS v4u*)(blk + OFF_U + (ct * 4 + dvt) * 2048 + (hh * 32 + c32) * 32);
                    v4u o0, o1;
                    o0.x = cvtpk(x[32 * ct + crow(0, hh)], x[32 * ct + crow(1, hh)]); o0.y = cvtpk(x[32 * ct + crow(2, hh)], x[32 * ct + crow(3, hh)]); o0.z = cvtpk(x[32 * ct + crow(4, hh)], x[32 * ct + crow(5, hh)]); o0.w = cvtpk(x[32 * ct + crow(6, hh)], x[32 * ct + crow(7, hh)]);
                    o1.x = cvtpk(x[32 * ct + crow(8, hh)], x[32 * ct + crow(9, hh)]); o1.y = cvtpk(x[32 * ct + crow(10, hh)], x[32 * ct + crow(11, hh)]); o1.z = cvtpk(x[32 * ct + crow(12, hh)], x[32 * ct + crow(13, hh)]); o1.w = cvtpk(x[32 * ct + crow(14, hh)], x[32 * ct + crow(15, hh)]);
                    d[0] = o0; d[1] = o1; }
        } else {
#pragma unroll
            for (int i = 0; i < 64; ++i) *(LAS unsigned short*)(L + L_WT + i * TP + col * 2) = (unsigned short)f2bf(-x[i]);
        }
    } else { const int w4 = wave - 4;
#pragma unroll 1
        for (int q = 0; q < 4; ++q) { const int f = w4 * 4 + q, rb = f >> 3, kt = (f >> 1) & 3, s = f & 1;
            exp_frag(L + L_QT, TP, 32 * rb, 32 * kt + 16 * s, EG, (GAS v4u*)(blk + OFF_QD + f * 1024), lane); }
#pragma unroll 1
        for (int q = 0; q < 4; ++q) { const int f = w4 * 4 + q, rb = f >> 2, ct = (f >> 1) & 1, s = f & 1;
            const int dk = 32 * rb + r32; float v[8];
#pragma unroll
            for (int j = 0; j < 8; ++j) { const int c = 32 * ct + 16 * s + 8 * (j >> 2) + 4 * hi + (j & 3); v[j] = bf2f(*(const LAS unsigned short*)(L + L_KT + c * TP + dk * 2)) * EGL[c]; }
            v4u o; o.x = cvtpk(v[0], v[1]); o.y = cvtpk(v[2], v[3]); o.z = cvtpk(v[4], v[5]); o.w = cvtpk(v[6], v[7]);
            ((GAS v4u*)(blk + OFF_KDT + f * 1024))[lane] = o; }
        if (w4 < 3)
#pragma unroll 1
        for (int q = 0; q < 2; ++q) { const int f = w4 * 2 + q, rb = w4 >= 1, ct = w4 == 2, s = q;
            exp_frag(L + L_AT, ATP, 32 * rb, 32 * ct + 16 * s, nullptr, (GAS v4u*)(blk + OFF_AT + f * 1024), lane); }
    }
    LDS_WAIT(); __builtin_amdgcn_s_barrier(); asm volatile("" ::: "memory");
#pragma unroll 1
    for (int q = 0; q < 2; ++q) { const int f = wave * 2 + q, rb = f >> 3, kt = (f >> 1) & 3, s = f & 1;
        exp_frag(L + L_WT, TP, 32 * rb, 32 * kt + 16 * s, nullptr, (GAS v4u*)(blk + OFF_W + f * 1024), lane); }
}

__device__ __forceinline__ void g2_pair(LAS unsigned char* L, int tid, int pair, const unsigned char* gws, const float* CD, const bf16* P, const float* dng, bf16* MIX) {
    const int lane = tid & 63, wave = __builtin_amdgcn_readfirstlane(tid >> 6), r32 = lane & 31, hi = lane >> 5;
    const int b = pair >> 3, h = pair & 7;
    const unsigned char* base = gws + (size_t)pair * 32 * CHB;
    if (wave >= 4) {
        const int lw = wave - 4, t = tid - 256, erow = t >> 2, eq = t & 3;
        float gg[32];
#pragma unroll
        for (int i = 0; i < 8; ++i) { const f32x4 v = *(const GAS f32x4*)(dng + 32 * eq + 4 * i); gg[4 * i] = v.x; gg[4 * i + 1] = v.y; gg[4 * i + 2] = v.z; gg[4 * i + 3] = v.w; }
        {   const unsigned char* src = base + lane * 16; LAS unsigned char* dst = L;
#pragma unroll
            for (int p = 0; p < 14; ++p) if (lw + 4 * p < 54) __builtin_amdgcn_global_load_lds((const GAS unsigned*)(src + (lw + 4 * p) * 1024), (LAS unsigned*)(dst + (lw + 4 * p) * 1024), 16, 0, 0);
            asm volatile("s_waitcnt vmcnt(0)" ::: "memory"); __builtin_amdgcn_s_barrier(); asm volatile("" ::: "memory"); }
        v4u zc[4], zn[4];
#pragma unroll
        for (int i = 0; i < 4; ++i) { zc[i] = (v4u){0u, 0u, 0u, 0u}; zn[i] = zc[i]; }
#pragma unroll 1
        for (int n = 0; n <= 32; ++n) {
            if (n < 32) { const GAS v4u* zp = (const GAS v4u*)(P + (size_t)(b * SEQ + 64 * n + erow) * PW + 6144 + h * 128 + 32 * eq);
                asm volatile("global_load_dwordx4 %0, %4, off\n\tglobal_load_dwordx4 %1, %4, off offset:16\n\tglobal_load_dwordx4 %2, %4, off offset:32\n\tglobal_load_dwordx4 %3, %4, off offset:48"
                             : "=&v"(zn[0]), "=&v"(zn[1]), "=&v"(zn[2]), "=&v"(zn[3]) : "v"(zp) : "memory"); }
            if (n + 1 < 32) { const unsigned char* src = base + (size_t)(n + 1) * CHB + lane * 16; LAS unsigned char* dst = L + ((n + 1) & 1) * ABYTES;
#pragma unroll
                for (int p = 0; p < 14; ++p) if (lw + 4 * p < 54) __builtin_amdgcn_global_load_lds((const GAS unsigned*)(src + (lw + 4 * p) * 1024), (LAS unsigned*)(dst + (lw + 4 * p) * 1024), 16, 0, 0); }
            if (n >= 1) { const size_t row = (size_t)(b * SEQ + 64 * (n - 1) + erow);
                v4u o[4];
#pragma unroll
                for (int i = 0; i < 4; ++i) o[i] = *(const LAS v4u*)(L + G2_OT + erow * OTP + eq * 64 + i * 16);
                float ov[32]; float ss = 0.f;
#pragma unroll
                for (int i = 0; i < 4; ++i) { ov[8 * i] = bflo(o[i].x); ov[8 * i + 1] = bfhi(o[i].x); ov[8 * i + 2] = bflo(o[i].y); ov[8 * i + 3] = bfhi(o[i].y); ov[8 * i + 4] = bflo(o[i].z); ov[8 * i + 5] = bfhi(o[i].z); ov[8 * i + 6] = bflo(o[i].w); ov[8 * i + 7] = bfhi(o[i].w); }
#pragma unroll
                for (int i = 0; i < 32; ++i) ss += ov[i] * ov[i];
                ss += __shfl_xor(ss, 1); ss += __shfl_xor(ss, 2);
                const float rn = 1.0f / sqrtf(ss * (1.f / 128.f) + GN_EPS);
                GAS v4u* mp = (GAS v4u*)(MIX + row * D + 1024 + h * 128 + 32 * eq);
#pragma unroll
                for (int i = 0; i < 4; ++i) { const v4u zz = zc[i]; v4u w;
                    w.x = cvtpk(ov[8 * i] * rn * gg[8 * i] * silu(bflo(zz.x)), ov[8 * i + 1] * rn * gg[8 * i + 1] * silu(bfhi(zz.x)));
                    w.y = cvtpk(ov[8 * i + 2] * rn * gg[8 * i + 2] * silu(bflo(zz.y)), ov[8 * i + 3] * rn * gg[8 * i + 3] * silu(bfhi(zz.y)));
                    w.z = cvtpk(ov[8 * i + 4] * rn * gg[8 * i + 4] * silu(bflo(zz.z)), ov[8 * i + 5] * rn * gg[8 * i + 5] * silu(bfhi(zz.z)));
                    w.w = cvtpk(ov[8 * i + 6] * rn * gg[8 * i + 6] * silu(bflo(zz.w)), ov[8 * i + 7] * rn * gg[8 * i + 7] * silu(bfhi(zz.w)));
                    mp[i] = w; }
            }
            if (n < 32) { LDS_WAIT(); __builtin_amdgcn_s_barrier(); asm volatile("" ::: "memory");
                if (n >= 1) asm volatile("s_waitcnt vmcnt(4)" ::: "memory"); else asm volatile("s_waitcnt vmcnt(0)" ::: "memory");
                asm volatile("" : "+v"(zn[0]), "+v"(zn[1]), "+v"(zn[2]), "+v"(zn[3]));
#pragma unroll
                for (int i = 0; i < 4; ++i) zc[i] = zn[i];
                __builtin_amdgcn_s_barrier(); asm volatile("" ::: "memory"); }
        }
    } else {
        f32x16 S[4];
#pragma unroll
        for (int kt = 0; kt < 4; ++kt)
#pragma unroll
            for (int r = 0; r < 16; ++r) S[kt][r] = 0.f;
        v4u un[2][2]; float cdn;
        { const GAS v4u* up = (const GAS v4u*)(base + OFF_U + wave * 2048 + lane * 32); un[0][0] = up[0]; un[0][1] = up[1]; up = (const GAS v4u*)(base + OFF_U + (4 + wave) * 2048 + lane * 32); un[1][0] = up[0]; un[1][1] = up[1]; cdn = CD[pair * 32]; }
        __builtin_amdgcn_s_barrier(); asm volatile("" ::: "memory");
#pragma unroll 1
        for (int n = 0; n < 32; ++n) {
            const LAS unsigned char* buf = L + (n & 1) * ABYTES + lane * 16;
            f32x16 vn[2], o[2]; const float cd = cdn;
#pragma unroll
            for (int ct = 0; ct < 2; ++ct) { const v4u a = un[ct][0], c = un[ct][1];
                vn[ct][0] = bflo(a.x); vn[ct][1] = bfhi(a.x); vn[ct][2] = bflo(a.y); vn[ct][3] = bfhi(a.y); vn[ct][4] = bflo(a.z); vn[ct][5] = bfhi(a.z); vn[ct][6] = bflo(a.w); vn[ct][7] = bfhi(a.w);
                vn[ct][8] = bflo(c.x); vn[ct][9] = bfhi(c.x); vn[ct][10] = bflo(c.y); vn[ct][11] = bfhi(c.y); vn[ct][12] = bflo(c.z); vn[ct][13] = bfhi(c.z); vn[ct][14] = bflo(c.w); vn[ct][15] = bfhi(c.w); }
            if (n + 1 < 32) { const unsigned char* nb = base + (size_t)(n + 1) * CHB; const GAS v4u* up = (const GAS v4u*)(nb + OFF_U + wave * 2048 + lane * 32); un[0][0] = up[0]; un[0][1] = up[1];
                up = (const GAS v4u*)(nb + OFF_U + (4 + wave) * 2048 + lane * 32); un[1][0] = up[0]; un[1][1] = up[1]; cdn = CD[pair * 32 + n + 1]; }
#define GDN_AF(off) (*(const LAS bf16x8*)(buf + (off)))
#define GDN_LD8(dst, base) do { _Pragma("unroll") for (int q_ = 0; q_ < 8; ++q_) dst[q_] = GDN_AF((base) + q_ * 1024); } while (0)
#define GDN_SB() __builtin_amdgcn_sched_barrier(0)
            bf16x8 fa[4], fb[4];
#define GDN_LDK(dst, kt, s) do { _Pragma("unroll") for (int q_ = 0; q_ < 4; ++q_) dst[q_] = GDN_AF(((q_ & 2) ? OFF_QD : OFF_W) + (((q_ & 1) * 4 + (kt)) * 2 + (s)) * 1024); } while (0)
#define GDN_STK(src, pk) do { const bf16x8 p_ = (pk); vn[0] = GDN_MFMA(src[0], p_, vn[0]); vn[1] = GDN_MFMA(src[1], p_, vn[1]); o[0] = GDN_MFMA(src[2], p_, o[0]); o[1] = GDN_MFMA(src[3], p_, o[1]); } while (0)
            GDN_LDK(fa, 0, 0);
#pragma unroll
            for (int r = 0; r < 16; ++r) { o[0][r] = 0.f; o[1][r] = 0.f; }
            GDN_SB(); GDN_LDK(fb, 0, 1); GDN_SB(); GDN_STK(fa, packB<0>(S[0]));
            GDN_SB(); GDN_LDK(fa, 1, 0); GDN_SB(); GDN_STK(fb, packB<1>(S[0]));
            GDN_SB(); GDN_LDK(fb, 1, 1); GDN_SB(); GDN_STK(fa, packB<0>(S[1]));
            GDN_SB(); GDN_LDK(fa, 2, 0); GDN_SB(); GDN_STK(fb, packB<1>(S[1]));
            GDN_SB(); GDN_LDK(fb, 2, 1); GDN_SB(); GDN_STK(fa, packB<0>(S[2]));
            GDN_SB(); GDN_LDK(fa, 3, 0); GDN_SB(); GDN_STK(fb, packB<1>(S[2]));
            GDN_SB(); GDN_LDK(fb, 3, 1); GDN_SB(); GDN_STK(fa, packB<0>(S[3]));
            GDN_SB();
#pragma unroll
            for (int q = 0; q < 4; ++q) fa[q] = GDN_AF(OFF_AT + q * 1024);
            GDN_SB(); GDN_STK(fb, packB<1>(S[3]));
#undef GDN_LDK
#undef GDN_STK
            bf16x8 pv[2][2];
#pragma unroll
            for (int ct = 0; ct < 2; ++ct) { pv[ct][0] = packB<0>(vn[ct]); pv[ct][1] = packB<1>(vn[ct]); }
            GDN_SB(); fb[0] = GDN_AF(OFF_AT + 4 * 1024); fb[1] = GDN_AF(OFF_AT + 5 * 1024); fb[2] = GDN_AF(OFF_KDT); fb[3] = GDN_AF(OFF_KDT + 1024); GDN_SB();
            o[0] = GDN_MFMA(fa[0], pv[0][0], o[0]); o[1] = GDN_MFMA(fa[2], pv[0][0], o[1]); o[0] = GDN_MFMA(fa[1], pv[0][1], o[0]); o[1] = GDN_MFMA(fa[3], pv[0][1], o[1]);
            GDN_SB(); fa[0] = GDN_AF(OFF_KDT + 2048); fa[1] = GDN_AF(OFF_KDT + 3072); fa[2] = GDN_AF(OFF_KDT + 4096); fa[3] = GDN_AF(OFF_KDT + 5120); GDN_SB();
#pragma unroll
            for (int r = 0; r < 16; ++r) { S[0][r] *= cd; S[1][r] *= cd; }
            o[1] = GDN_MFMA(fb[0], pv[1][0], o[1]); S[0] = GDN_MFMA(fb[2], pv[0][0], S[0]); o[1] = GDN_MFMA(fb[1], pv[1][1], o[1]); S[0] = GDN_MFMA(fb[3], pv[0][1], S[0]);
            GDN_SB(); fb[0] = GDN_AF(OFF_KDT + 6144); fb[1] = GDN_AF(OFF_KDT + 7168); fb[2] = GDN_AF(OFF_KDT + 8192); fb[3] = GDN_AF(OFF_KDT + 9216); GDN_SB();
            S[0] = GDN_MFMA(fa[0], pv[1][0], S[0]); S[1] = GDN_MFMA(fa[2], pv[0][0], S[1]); S[0] = GDN_MFMA(fa[1], pv[1][1], S[0]); S[1] = GDN_MFMA(fa[3], pv[0][1], S[1]);
            GDN_SB(); fa[0] = GDN_AF(OFF_KDT + 10240); fa[1] = GDN_AF(OFF_KDT + 11264); fa[2] = GDN_AF(OFF_KDT + 12288); fa[3] = GDN_AF(OFF_KDT + 13312); GDN_SB();
#pragma unroll
            for (int r = 0; r < 16; ++r) { S[2][r] *= cd; S[3][r] *= cd; }
            S[1] = GDN_MFMA(fb[0], pv[1][0], S[1]); S[2] = GDN_MFMA(fb[2], pv[0][0], S[2]); S[1] = GDN_MFMA(fb[1], pv[1][1], S[1]); S[2] = GDN_MFMA(fb[3], pv[0][1], S[2]);
            GDN_SB(); fb[0] = GDN_AF(OFF_KDT + 14336); fb[1] = GDN_AF(OFF_KDT + 15360); GDN_SB();
            S[2] = GDN_MFMA(fa[0], pv[1][0], S[2]); S[3] = GDN_MFMA(fa[2], pv[0][0], S[3]); S[2] = GDN_MFMA(fa[1], pv[1][1], S[2]); S[3] = GDN_MFMA(fa[3], pv[0][1], S[3]);
            GDN_SB();
            S[3] = GDN_MFMA(fb[0], pv[1][0], S[3]); S[3] = GDN_MFMA(fb[1], pv[1][1], S[3]);
#undef GDN_AF
#undef GDN_LD8
#undef GDN_SB
            LDS_WAIT(); __builtin_amdgcn_s_barrier(); asm volatile("" ::: "memory");
#pragma unroll
            for (int ct = 0; ct < 2; ++ct)
#pragma unroll
                for (int r = 0; r < 16; ++r) *(LAS unsigned short*)(L + G2_OT + (32 * ct + crow(r, hi)) * OTP + (32 * wave + r32) * 2) = (unsigned short)f2bf(o[ct][r]);
            LDS_WAIT(); __builtin_amdgcn_s_barrier(); asm volatile("" ::: "memory");
        }
    }
}
__device__ __forceinline__ void diff_combine_blocks(int wave, int lane, const bf16* OB, bf16* MIX, const float* dg, float lam, float oml, int b, int h, unsigned qbmask) {
    const int sub = lane >> 4, c16 = lane & 15, vh = c16 >> 3, dd = (8 * c16) & 63;
    const f32x4 g0 = *(const GAS f32x4*)(dg + 8 * c16) * oml, g1 = *(const GAS f32x4*)(dg + 8 * c16 + 4) * oml;
    for (int qb = 0; qb < 8; ++qb) { if (!((qbmask >> qb) & 1u)) continue;
#pragma unroll 1
        for (int it0 = wave * 4; it0 < 64; it0 += NWAVES * 4) {
            v4u a[4], c[4];
#pragma unroll
            for (int q = 0; q < 4; ++q) { const int r = b * SEQ + 256 * qb + (it0 + q) * 4 + sub;
                a[q] = *(const GAS v4u*)(OB + (size_t)r * D + ((h * 2 + 0) * 2 + vh) * 64 + dd); c[q] = *(const GAS v4u*)(OB + (size_t)r * D + ((h * 2 + 1) * 2 + vh) * 64 + dd); }
#pragma unroll
            for (int q = 0; q < 4; ++q) { const int r = b * SEQ + 256 * qb + (it0 + q) * 4 + sub;
                float o[8]; o[0] = bflo(a[q].x) - lam * bflo(c[q].x); o[1] = bfhi(a[q].x) - lam * bfhi(c[q].x); o[2] = bflo(a[q].y) - lam * bflo(c[q].y); o[3] = bfhi(a[q].y) - lam * bfhi(c[q].y);
                o[4] = bflo(a[q].z) - lam * bflo(c[q].z); o[5] = bfhi(a[q].z) - lam * bfhi(c[q].z); o[6] = bflo(a[q].w) - lam * bflo(c[q].w); o[7] = bfhi(a[q].w) - lam * bfhi(c[q].w);
                float ss = 0.f;
#pragma unroll
                for (int e = 0; e < 8; ++e) ss += o[e] * o[e];
                ss += __shfl_xor(ss, 1); ss += __shfl_xor(ss, 2); ss += __shfl_xor(ss, 4); ss += __shfl_xor(ss, 8);
                const float rn = 1.0f / sqrtf(ss * (1.f / 128.f) + SUBLN_EPS);
                v4u w; w.x = cvtpk(o[0] * rn * g0.x, o[1] * rn * g0.y); w.y = cvtpk(o[2] * rn * g0.z, o[3] * rn * g0.w); w.z = cvtpk(o[4] * rn * g1.x, o[5] * rn * g1.y); w.w = cvtpk(o[6] * rn * g1.z, o[7] * rn * g1.w);
                *(GAS v4u*)(MIX + (size_t)r * D + h * 128 + 8 * c16) = w; } } }
}
}
struct Args { const void* in[23]; float* out; unsigned char* ws; int ph_lo, ph_hi; };
#define PH_BEGIN() asm volatile("" ::: "memory"); int tid = threadIdx.x; asm volatile("" : "+v"(tid)); int bx_ = blockIdx.x; asm volatile("" : "+s"(bx_)); \
    const int lane = tid & 63, wave = __builtin_amdgcn_readfirstlane(tid >> 6), G = gridDim.x, vcu = (G % 8 == 0) ? (bx_ % 8) * (G / 8) + bx_ / 8 : bx_; \
    unsigned char* const ws = ptab(I_WS); (void)lane; (void)wave; (void)vcu; (void)ws
#define GWAVES() const int gw = vcu * NWAVES + wave, NGW = G * NWAVES
#define PIN_F(i) ((const float*)ptab(i))


__device__ __forceinline__ void ba_rows(const bf16* XB, const bf16* WBA, const float* stats, const float* cs, const float* bw, float* BA, int row0, int lane) {
    const int r16 = lane & 15, kq = lane >> 4;
    const GAS v4u* ap = (const GAS v4u*)(XB + (size_t)(row0 + r16) * D + 8 * kq);
    const GAS v4u* bp = (const GAS v4u*)(WBA + (size_t)r16 * D + 8 * kq);
    f32x4 acc0 = (f32x4){0.f, 0.f, 0.f, 0.f}, acc1 = acc0;
    v4u a[2][8], b[2][8];
#define BA_LOAD(u_, bt_) do { _Pragma("unroll") for (int j = 0; j < 8; ++j) { a[u_][j] = ap[((bt_) * 8 + j) * 4]; b[u_][j] = bp[((bt_) * 8 + j) * 4]; } } while (0)
#define BA_MUL(u_) do { _Pragma("unroll") for (int j = 0; j < 8; j += 2) { \
        acc0 = __builtin_amdgcn_mfma_f32_16x16x32_bf16(__builtin_bit_cast(bf16x8, a[u_][j]), __builtin_bit_cast(bf16x8, b[u_][j]), acc0, 0, 0, 0); \
        acc1 = __builtin_amdgcn_mfma_f32_16x16x32_bf16(__builtin_bit_cast(bf16x8, a[u_][j + 1]), __builtin_bit_cast(bf16x8, b[u_][j + 1]), acc1, 0, 0, 0); } } while (0)
    BA_LOAD(0, 0);
#pragma unroll 1
    for (int bt = 0; bt < 8; bt += 2) {
        BA_LOAD(1, bt + 1);
        BA_MUL(0);
        if (bt + 2 < 8) BA_LOAD(0, bt + 2);
        BA_MUL(1);
    }
#undef BA_LOAD
#undef BA_MUL
    const f32x4 acc = acc0 + acc1;
    const float c_ = cs[7168 + r16], w_ = bw[7168 + r16];
#pragma unroll
    for (int i = 0; i < 4; ++i) { const int row = row0 + 4 * kq + i; const f32x2 st = *(const GAS f32x2*)(stats + 2 * (size_t)row);
        BA[(size_t)row * 16 + r16] = (acc[i] - c_ * st.x) * st.y + w_; }
}
__device__ __forceinline__ void convert_ffn(int fj, unsigned char* ws, LAS unsigned char* L, int vcu, int G, int wave, int lane) {
    const int l = fj >> 1, second = fj & 1, lp = l > 0 ? l - 1 : 0; const bool hasln = fj > 0;
    const float* w_in_f = PIN_F(second ? I_F2IN : I_F1IN) + (size_t)l * D * NFI; const float* w_out_f = PIN_F(second ? I_F2OUT : I_F1OUT) + (size_t)l * DFF * D;
    const float* lg = second ? PIN_F(I_LN2G) + (size_t)l * D : PIN_F(I_LN3G) + (size_t)lp * D;
    const float* lb = second ? PIN_F(I_LN2B) + (size_t)l * D : PIN_F(I_LN3B) + (size_t)lp * D;
    bf16* WFI = (bf16*)(ws + WS_WFI); bf16* WFO = (bf16*)(ws + (second ? WS_WFO2 : WS_WFO));
    LAS float* scr = (LAS float*)(L + RING_OFF + wave * 16384); LAS float* part = (LAS float*)(L + RING_OFF + 7 * 16384 + 12288);
    constexpr int I_A = NFI / 32, I_B = (DFF / 64) * (D / 32); const int gw = vcu * NWAVES + wave, NGW = G * NWAVES;
    for (int nb = vcu; nb < I_A; nb += G) fold_task(w_in_f, D, NFI, NFI, WFI, RmFfnIn(), lg, lb, hasln, (float*)(ws + WS_CSF), (float*)(ws + WS_BWF), scr, part, nb, wave, lane);
    for (int it = gw; it < I_B; it += NGW) transpose_item(w_out_f, DFF, D, D, WFO, RmId(), scr, it, lane);
}
__device__ __forceinline__ void convert_mixer(int l, unsigned char* ws, LAS unsigned char* L, int vcu, int G, int wave, int lane) {
    const float* wi = PIN_F(I_WIN) + (size_t)l * D * NIN; const float* wo = PIN_F(I_WOUT) + (size_t)l * D * D;
    const float* lg = PIN_F(I_LN1G) + (size_t)l * D; const float* lb = PIN_F(I_LN1B) + (size_t)l * D;
    bf16* WIN = (bf16*)(ws + WS_WIN); bf16* WOUT = (bf16*)(ws + WS_WOUT);
    LAS float* scr = (LAS float*)(L + RING_OFF + wave * 16384); LAS float* part = (LAS float*)(L + RING_OFF + 7 * 16384 + 12288);
    constexpr int I_A = (NIN + 31) / 32, I_B = (D / 64) * (D / 32); const int gw = vcu * NWAVES + wave, NGW = G * NWAVES;
    for (int nb = vcu; nb < I_A; nb += G) fold_task(wi, D, NIN, NINP, WIN, RmMixIn(), lg, lb, true, (float*)(ws + WS_CSI), (float*)(ws + WS_BWI), scr, part, nb, wave, lane);
    for (int it = gw; it < I_B; it += NGW) transpose_item(wo, D, D, D, WOUT, RmId(), scr, it, lane);
}

__global__ void __launch_bounds__(NWAVES * 64, 2) hyb_fwd(Args args) {
    extern __shared__ __attribute__((aligned(16))) unsigned char lds[];
    LAS unsigned char* const L = (LAS unsigned char*)lds;
    for (int u = threadIdx.x; u < (LDS_BYTES - LDSCTL_OFF) / 4; u += NWAVES * 64) ((LAS unsigned*)(L + LDSCTL_OFF))[u] = 0u;
    __syncthreads();
    if (threadIdx.x == 0) { LAS unsigned long long* t = (LAS unsigned long long*)(L + PTAB_OFF);
#pragma unroll
        for (int i = 0; i < 23; ++i) t[i] = (unsigned long long)args.in[i];
        t[I_OUT] = (unsigned long long)args.out; t[I_WS] = (unsigned long long)args.ws; }
    __syncthreads();
    const int lo = args.ph_lo, hi = args.ph_hi;
    if (hi - lo > 1) (void)xcd_barrier_post((unsigned*)((gu32*)args.ws + CW_BAR), (volatile LAS unsigned*)(L + MISC_OFF) + 8);
#define IN(k) (lo <= (k) && (k) < hi)
#define SEAM(k) do { if ((k) + 1 < hi) { XcdBarrier b_; b_.bar = (unsigned*)ptab(I_WS) + CW_BAR; b_.x = xb_xcc_id(); b_.st = (volatile LAS unsigned*)(L + MISC_OFF) + 8; xcd_barrier(b_); } } while (0)

    if (IN(0)) {
        PH_BEGIN(); const int gt = vcu * (NWAVES * 64) + tid, NGT = G * NWAVES * 64;
        const int* pos = (const int*)ptab(I_POS); const float* x_in = PIN_F(I_X); float* ROPE = (float*)(ws + WS_ROPE); bf16* XB = (bf16*)(ws + WS_XB);
        for (int i = gt; i < M * 8; i += NGT) { const int r = i >> 3, k = i & 7;
            const float invf = (float)pow(500000.0, -(double)(2 * k) / 16.0);
            const float ang = (float)pos[r] * invf;
            ROPE[(size_t)r * 16 + k] = (float)cos((double)ang); ROPE[(size_t)r * 16 + 8 + k] = (float)sin((double)ang); }
        for (int r = gt; r < M; r += NGT) *(GAS f32x2*)((float*)(ws + WS_STATS) + 2 * (size_t)r) = (f32x2){0.f, 1.f};
        for (size_t i = (size_t)gt; i < (size_t)M * D / 4; i += NGT) { const f32x4 v = ((const GAS f32x4*)x_in)[i];
            const unsigned h01 = pk2(v.x, v.y), h23 = pk2(v.z, v.w);
            ((GAS unsigned long long*)XB)[i] = (unsigned long long)h01 | ((unsigned long long)h23 << 32);
            int lw_ = __builtin_amdgcn_cvt_pk_bf8_f32((v.x - bflo(h01)) * YLO_S, (v.y - bfhi(h01)) * YLO_S, 0, false); lw_ = __builtin_amdgcn_cvt_pk_bf8_f32((v.z - bflo(h23)) * YLO_S, (v.w - bfhi(h23)) * YLO_S, lw_, true);
            ((GAS unsigned*)(ws + WS_YLO))[i] = (unsigned)lw_; }
        convert_ffn(0, ws, L, vcu, G, wave, lane);
        SEAM(0);
    }

    for (int fi = 0; fi < NFFN; ++fi) {
        const int l = fi >> 1, second = fi & 1, pb = 1 + SLOTS * fi;
        if (fi > 0 && IN(pb + 0)) {
            PH_BEGIN();
            finalize_stats((const float*)(ws + WS_PS), (float*)(ws + WS_STATS), vcu * (NWAVES * 64) + tid, G * NWAVES * 64);
            SEAM(pb + 0);
        }
#pragma unroll 1
        for (int hf = 0; hf < FFN_SPLIT; ++hf) {
        if (IN(pb + 1)) {
            PH_BEGIN();
            pg8::Gemm g{(const bf16*)(ws + WS_XB), (const bf16*)(ws + WS_WFI), M, NFI, D}; pg8::StaticOrderOff S; S.init(M / FFN_SPLIT, NFI, G, bx_); S.pm0 = hf * (M / FFN_SPLIT / 256);
            pg8::EpiSwiGLU E{0};
            pg8::gemm_phase<pg8::EpiSwiGLU, pg8::StaticOrderOff, PG8_ALIGN, PG8_SP2>(L + RING_OFF, g, S, E);
            SEAM(pb + 1);
        }
        if (IN(pb + 2)) {
            PH_BEGIN();
            const bool hasln = fi > 0; const int lp = l > 0 ? l - 1 : 0;
            const bool conv_first = (vcu & 1) == 0, have_next = !second || l + 1 < DEPTH;
            if (conv_first && have_next) { if (!second) convert_mixer(l, ws, L, vcu, G, wave, lane); else convert_ffn(fi + 1, ws, L, vcu, G, wave, lane); VM_WAIT(); __syncthreads(); }
            { pg8::Gemm g{(const bf16*)(ws + WS_HP), (const bf16*)(ws + (second ? WS_WFO2 : WS_WFO)), M, D, DFF}; pg8::StaticOrderOff S; S.init(M / FFN_SPLIT, D, G, bx_); S.pm0 = hf * (M / FFN_SPLIT / 256);
            pg8::EpiResLN E{second ? (int)I_LN2G : (int)I_LN3G, second ? (int)I_LN2B : (int)I_LN3B, (second ? l : lp) * D, ALPHA, 0.5f, hasln};
            pg8::gemm_phase<pg8::EpiResLN, pg8::StaticOrderOff, PG8_ALIGN, PG8_SP2>(L + RING_OFF, g, S, E); }
            if (!conv_first && have_next) { VM_WAIT(); __syncthreads(); int w2_ = threadIdx.x; asm volatile("" : "+v"(w2_)); const int wave2 = __builtin_amdgcn_readfirstlane(w2_ >> 6), lane2 = w2_ & 63;
                if (!second) convert_mixer(l, ws, L, vcu, G, wave2, lane2); else convert_ffn(fi + 1, ws, L, vcu, G, wave2, lane2); }
            SEAM(pb + 2);
        }
        }
        if (second) continue;
        if (IN(pb + 4)) {
            PH_BEGIN();
            finalize_stats((const float*)(ws + WS_PS), (float*)(ws + WS_STATS), vcu * (NWAVES * 64) + tid, G * NWAVES * 64);
            SEAM(pb + 4);
        }
        if (IN(pb + 5)) {
            PH_BEGIN();
#define BA_JOB() do { int ln_ = threadIdx.x; asm volatile("" : "+v"(ln_)); for (int rb = vcu; rb < M / 128; rb += G) \
                ba_rows((const bf16*)(ws + WS_XB), (const bf16*)(ws + WS_WIN) + (size_t)PW * D, (const float*)(ws + WS_STATS), (const float*)(ws + WS_CSI), (const float*)(ws + WS_BWI), (float*)(ws + WS_BA), rb * 128 + (ln_ >> 6) * 16, ln_ & 63); } while (0)
            if (!(vcu & 1)) BA_JOB();
            pg8::Gemm g{(const bf16*)(ws + WS_XB), (const bf16*)(ws + WS_WIN), M, PW, D}; pg8::StaticOrder S; S.init(M, PW, G, bx_);
            pg8::EpiInProj E{QSCALE};
            pg8::gemm_phase<pg8::EpiInProj, pg8::StaticOrder, PG8_ALIGN, PG8_SP2>(L + RING_OFF, g, S, E);
            if (vcu & 1) BA_JOB();
#undef BA_JOB
            SEAM(pb + 5);
        }
        if (IN(pb + 6)) {
            { PH_BEGIN(); const float* cw = PIN_F(I_CONVW) + (size_t)l * 4 * 3072; const float aexp = __expf(PIN_F(I_ALOG)[l * NH + 0]);
            (void)aexp;
            for (int ci = vcu; ci < BATCH * NH * 32; ci += G) { const int h = (ci >> 5) & 7;
                gdn::g1_chunk(L + RING_OFF, tid, ci, (const bf16*)(ws + WS_HP), (const float*)(ws + WS_BA), cw, __expf(PIN_F(I_ALOG)[l * NH + h]), PIN_F(I_DTB)[l * NH + h], ws + WS_GDN + (size_t)ci * gdn::CHB, (float*)(ws + WS_CD)); }
            VM_WAIT(); __syncthreads(); }
            SEAM(pb + 6);
        }
        if (IN(pb + 7)) {
            PH_BEGIN();
            for (int v = vcu; v < 2 * BATCH * NH; v += G) { const int pair = v >> 1, b = pair >> 3, h = pair & 7; const unsigned qbmask = (v & 1) ? (0xFFu ^ X3_MASK0) : X3_MASK0;
                if (!(v & 1)) { int tid2_ = threadIdx.x; asm volatile("" : "+v"(tid2_)); gdn::g2_pair(L + RING_OFF, tid2_, pair, ws + WS_GDN, (const float*)(ws + WS_CD), (const bf16*)(ws + WS_HP), PIN_F(I_DELTAG) + l * 128, (bf16*)(ws + WS_MIX)); VM_WAIT(); __syncthreads(); }
                int ln_ = threadIdx.x & 63; asm volatile("" : "+v"(ln_));
                const float lam_init = 0.8f - 0.6f * expf(-0.3f * (float)l);
                const float lam_v = expf(wave_sum(PIN_F(I_LQ1)[l * 64 + ln_] * PIN_F(I_LK1)[l * 64 + ln_])) - expf(wave_sum(PIN_F(I_LQ2)[l * 64 + ln_] * PIN_F(I_LK2)[l * 64 + ln_])) + lam_init;
                const float lam = __builtin_bit_cast(float, __builtin_amdgcn_readfirstlane(__builtin_bit_cast(int, lam_v)));
                attn_body::attn_head_blocks<8>((char*)lds + RING_OFF, (const attn_body::bf16*)(ws + WS_HP), (attn_body::bf16*)(ws + WS_O), (attn_body::bf16*)(ws + WS_MIX), PIN_F(I_DIFFG) + l * 128, lam, 1.0f - lam_init, SUBLN_EPS, b, h, qbmask);
                VM_WAIT(); __syncthreads();
            }
            SEAM(pb + 7);
        }
        if (IN(pb + 9)) {
            PH_BEGIN();
            const bool conv_first = (vcu & 1) == 0;
            if (conv_first) { convert_ffn(fi + 1, ws, L, vcu, G, wave, lane); VM_WAIT(); __syncthreads(); }
            { pg8::Gemm g{(const bf16*)(ws + WS_MIX), (const bf16*)(ws + WS_WOUT), M, D, D}; pg8::StaticOrder S; S.init(M, D, G, bx_);
            pg8::EpiResLN E{(int)I_LN1G, (int)I_LN1B, l * D, ALPHA, 1.0f, true};
            pg8::gemm_phase<pg8::EpiResLN, pg8::StaticOrder, PG8_ALIGN, PG8_SP2>(L + RING_OFF, g, S, E); }
            if (!conv_first) { VM_WAIT(); __syncthreads(); int w2_ = threadIdx.x; asm volatile("" : "+v"(w2_)); convert_ffn(fi + 1, ws, L, vcu, G, __builtin_amdgcn_readfirstlane(w2_ >> 6), w2_ & 63); }
            SEAM(pb + 9);
        }
    }
    if (IN(NPH - 1)) {
        PH_BEGIN(); GWAVES(); float* XF = (float*)ptab(I_OUT); const float* PS = (const float*)(ws + WS_PS);
        const float* g3 = PIN_F(I_LN3G) + (size_t)(DEPTH - 1) * D; const float* b3 = PIN_F(I_LN3B) + (size_t)(DEPTH - 1) * D;
        for (int m = gw; m < M; m += NGW) final_ln_row(XF + (size_t)m * D, (const bf16*)(ws + WS_XB) + (size_t)m * D, (const unsigned char*)(ws + WS_YLO) + (size_t)m * D, PS + (size_t)m * 64, g3, b3, lane);
    }
#undef IN
#undef SEAM
}

extern "C" void kernel_launch(void* const* d_in, const int* in_sizes, int n_in, void* d_out, int out_size, void* d_ws, size_t ws_size, hipStream_t stream) {
    static int grid = 0;
    if (grid == 0) {
        if (n_in != 23 || in_sizes[0] != M * D || out_size != M * D || ws_size < WS_END) { fprintf(stderr, "kernel_launch: unexpected shapes (n_in %d, in0 %d, out %d, ws %zu); nothing launched\n", n_in, n_in > 0 ? in_sizes[0] : -1, out_size, ws_size); grid = -1; return; }
        int dev = 0, cus = 0, per_cu = 0;
        if (hipGetDevice(&dev) != hipSuccess || hipDeviceGetAttribute(&cus, hipDeviceAttributeMultiprocessorCount, dev) != hipSuccess) { grid = -1; return; }
        if (hipFuncSetAttribute((const void*)hyb_fwd, hipFuncAttributeMaxDynamicSharedMemorySize, LDS_BYTES) != hipSuccess) { fprintf(stderr, "kernel_launch: hipFuncSetAttribute failed\n"); grid = -1; return; }
        if (hipOccupancyMaxActiveBlocksPerMultiprocessor(&per_cu, (const void*)hyb_fwd, NWAVES * 64, LDS_BYTES) != hipSuccess || per_cu < 1) fprintf(stderr, "kernel_launch: occupancy query says %d\n", per_cu);
        (void)hipGetLastError();
        grid = cus;
    }
    if (grid < 0) return;
    if (hipMemsetAsync((char*)d_ws + WS_CTL, 0, CTL_ZERO_BYTES, stream) != hipSuccess) return;
    Args a{};
    for (int i = 0; i < 23; ++i) a.in[i] = d_in[i];
    a.out = (float*)d_out; a.ws = (unsigned char*)d_ws;
#if MK_ONE_LAUNCH
    a.ph_lo = 0; a.ph_hi = NPH;
    hipLaunchKernelGGL(hyb_fwd, dim3(grid), dim3(NWAVES * 64), LDS_BYTES, stream, a);
#else
    for (int ph = 0; ph < NPH; ++ph) {
        if (ph > 0 && ph < NPH - 1) { const int fi = (ph - 1) / SLOTS, slot = (ph - 1) % SLOTS; if (((fi & 1) && slot >= 4) || slot == 3 || slot == 8 || slot == 10) continue; }
        a.ph_lo = ph; a.ph_hi = ph + 1;
        hipLaunchKernelGGL(hyb_fwd, dim3(grid), dim3(NWAVES * 64), LDS_BYTES, stream, a);
    }
#endif
}
```
